# Optimizing an MI355X kernel written in HIP

```python
import math
import jax, jax.numpy as jnp
from jax import lax
import numpy as np

D_MODEL = 1024
BATCH = 4
SEQ = 4096
DEPTH = 1

SSM_CH = 16
D_SSM = 512
SSM_GROUPS = D_SSM // SSM_CH
SSM_STATE = 64
N_HEADS = 8
HEAD_DIM = 64
D_ATTN = N_HEADS * HEAD_DIM
D_MIX = D_SSM + D_ATTN
IDX_HEADS = 8
IDX_DIM = 64
TOPK_MAX = 256
Q_BLOCK = 128
D_FF = 2816
CONV_W = 3
ROPE_THETA = 10000.0
EPS = 1e-6
D_IN_PROJ = D_SSM + 3 * D_ATTN + IDX_HEADS * IDX_DIM + IDX_DIM + IDX_HEADS

kernel_name = "hymba_s5_dsa_convffn_adaln"


def _rmsnorm(x, g):
    xf = x.astype(jnp.float32)
    return xf * lax.rsqrt(jnp.mean(xf * xf, axis=-1, keepdims=True) + EPS) * g.astype(jnp.float32)


def _modulate(xn, shift, scale):
    return xn * (1.0 + scale[:, None, :].astype(jnp.float32)) + shift[:, None, :].astype(jnp.float32)


def _rope(x, pos):
    d = x.shape[-1]
    inv = ROPE_THETA ** (-jnp.arange(0, d, 2, dtype=jnp.float32) / d)
    ang = pos.astype(jnp.float32)[..., None] * inv
    cos = jnp.cos(ang)[:, :, None, :]
    sin = jnp.sin(ang)[:, :, None, :]
    xf = x.astype(jnp.float32)
    x1, x2 = xf[..., : d // 2], xf[..., d // 2:]
    return jnp.concatenate([x1 * cos - x2 * sin, x1 * sin + x2 * cos], axis=-1)


def _s5_mixer(u, log_dt, a_re, a_im, b_re, b_im, c_re, c_im, d_skip, w_glu, b_glu):
    bsz, L, _ = u.shape
    uf = u.astype(jnp.float32).reshape(bsz, L, SSM_GROUPS, SSM_CH)
    dt = jnp.exp(log_dt.astype(jnp.float32))[:, None]
    lr = a_re.astype(jnp.float32)
    li = a_im.astype(jnp.float32)
    mag = jnp.exp(lr * dt)
    lb_re = mag * jnp.cos(li * dt)
    lb_im = mag * jnp.sin(li * dt)
    den = lr * lr + li * li
    nr, ni = lb_re - 1.0, lb_im
    coef_re = (nr * lr + ni * li) / den
    coef_im = (ni * lr - nr * li) / den
    br = b_re.astype(jnp.float32)
    bi = b_im.astype(jnp.float32)
    bb_re = coef_re[..., None] * br - coef_im[..., None] * bi
    bb_im = coef_re[..., None] * bi + coef_im[..., None] * br
    bu_re = jnp.einsum('blgc,gpc->blgp', uf, bb_re)
    bu_im = jnp.einsum('blgc,gpc->blgp', uf, bb_im)
    a_re_t = jnp.broadcast_to(lb_re, bu_re.shape)
    a_im_t = jnp.broadcast_to(lb_im, bu_im.shape)

    def combine(e1, e2):
        a1r, a1i, b1r, b1i = e1
        a2r, a2i, b2r, b2i = e2
        return (a2r * a1r - a2i * a1i,
                a2r * a1i + a2i * a1r,
                a2r * b1r - a2i * b1i + b2r,
                a2r * b1i + a2i * b1r + b2i)

    _, _, xr, xi = lax.associative_scan(combine, (a_re_t, a_im_t, bu_re, bu_im), axis=1)
    y = (jnp.einsum('blgp,gcp->blgc', xr, c_re.astype(jnp.float32))
         - jnp.einsum('blgp,gcp->blgc', xi, c_im.astype(jnp.float32))
         + d_skip.astype(jnp.float32).reshape(SSM_GROUPS, SSM_CH) * uf)
    y = jax.nn.gelu(y.reshape(bsz, L, D_SSM))
    return y * jax.nn.sigmoid(y @ w_glu.astype(jnp.float32) + b_glu.astype(jnp.float32))


def _dsa_mixer(q, k, v, qi, ki, wi):
    bsz, L = q.shape[0], q.shape[1]
    topk = min(TOPK_MAX, L // 4)
    nblk = L // Q_BLOCK
    scale = 1.0 / math.sqrt(HEAD_DIM)
    key_pos = jnp.arange(L, dtype=jnp.int32)

    def to_blocks(t):
        t = t.reshape((bsz, nblk, Q_BLOCK) + t.shape[2:])
        return jnp.moveaxis(t, 1, 0)

    def one_block(args):
        qb, qib, wib, start = args
        qpos = start + jnp.arange(Q_BLOCK, dtype=jnp.int32)
        s_h = jnp.einsum('bthd,bsd->bths', qib, ki)
        s_idx = jnp.einsum('bths,bth->bts', jax.nn.relu(s_h), wib)
        causal = key_pos[None, :] <= qpos[:, None]
        s_idx = jnp.where(causal[None], s_idx, -jnp.inf)
        _, sel = lax.top_k(s_idx, topk)
        valid = sel <= qpos[None, :, None]
        kg = jax.vmap(lambda kk, ii: kk[ii])(k, sel)
        vg = jax.vmap(lambda vv, ii: vv[ii])(v, sel)
        logits = jnp.einsum('bthd,btkhd->bhtk', qb, kg) * scale
        logits = jnp.where(valid[:, None], logits, -jnp.inf)
        p = jax.nn.softmax(logits, axis=-1)
        return jnp.einsum('bhtk,btkhd->bthd', p, vg.astype(jnp.float32))

    starts = jnp.arange(nblk, dtype=jnp.int32) * Q_BLOCK
    out = lax.map(one_block, (to_blocks(q), to_blocks(qi), to_blocks(wi), starts))
    out = jnp.moveaxis(out, 0, 1)
    return out.reshape(bsz, L, D_ATTN)


def _causal_dwconv(h, w, b):
    L = h.shape[1]
    hp = jnp.pad(h, ((0, 0), (CONV_W - 1, 0), (0, 0)))
    out = b.astype(jnp.float32)
    for j in range(CONV_W):
        out = out + w[j].astype(jnp.float32) * hp[:, j:j + L, :]
    return out


def setup_inputs(seed: int = 0) -> dict:
    key = jax.random.key(seed)
    ks = jax.random.split(key, 32)
    f32 = jnp.float32
    nrm = lambda k, shape, s: (jax.random.normal(k, shape, f32) * s)
    Dp = DEPTH
    x = jax.random.normal(ks[0], (BATCH, SEQ, D_MODEL), f32)
    c = jax.random.normal(ks[1], (BATCH, D_MODEL), f32)
    positions = jnp.broadcast_to(jnp.arange(SEQ, dtype=jnp.int32), (BATCH, SEQ))
    w_ada = nrm(ks[2], (Dp, D_MODEL, 6 * D_MODEL), 0.5 * D_MODEL ** -0.5)
    b_ada = nrm(ks[3], (Dp, 6 * D_MODEL), 0.02)
    norm_mix = 1.0 + nrm(ks[4], (Dp, D_MODEL), 0.02)
    w_in = nrm(ks[5], (Dp, D_MODEL, D_IN_PROJ), D_MODEL ** -0.5)
    ssm_log_dt = jax.random.uniform(ks[6], (Dp, SSM_GROUPS), f32, math.log(1e-3), math.log(1e-1))
    ssm_a_re = -0.5 + nrm(ks[7], (Dp, SSM_GROUPS, SSM_STATE), 0.01)
    ssm_a_im = (math.pi * jnp.arange(SSM_STATE, dtype=f32))[None, None, :] + nrm(ks[8], (Dp, SSM_GROUPS, SSM_STATE), 0.01)
    ssm_b_re = nrm(ks[9], (Dp, SSM_GROUPS, SSM_STATE, SSM_CH), (2 * SSM_CH) ** -0.5)
    ssm_b_im = nrm(ks[10], (Dp, SSM_GROUPS, SSM_STATE, SSM_CH), (2 * SSM_CH) ** -0.5)
    ssm_c_re = nrm(ks[11], (Dp, SSM_GROUPS, SSM_CH, SSM_STATE), (2 * SSM_STATE) ** -0.5)
    ssm_c_im = nrm(ks[12], (Dp, SSM_GROUPS, SSM_CH, SSM_STATE), (2 * SSM_STATE) ** -0.5)
    ssm_d = nrm(ks[13], (Dp, D_SSM), 1.0)
    ssm_w_glu = nrm(ks[14], (Dp, D_SSM, D_SSM), D_SSM ** -0.5)
    ssm_b_glu = nrm(ks[15], (Dp, D_SSM), 0.01)
    q_norm = 1.0 + nrm(ks[16], (Dp, HEAD_DIM), 0.02)
    k_norm = 1.0 + nrm(ks[17], (Dp, HEAD_DIM), 0.02)
    out_norm_ssm = 1.0 + nrm(ks[18], (Dp, D_SSM), 0.02)
    out_norm_attn = 1.0 + nrm(ks[19], (Dp, D_ATTN), 0.02)
    w_out = nrm(ks[20], (Dp, D_MIX, D_MODEL), D_MIX ** -0.5)
    norm_ffn = 1.0 + nrm(ks[21], (Dp, D_MODEL), 0.02)
    w_up = nrm(ks[22], (Dp, D_MODEL, 2 * D_FF), D_MODEL ** -0.5)
    conv_w = nrm(ks[23], (Dp, CONV_W, 2 * D_FF), CONV_W ** -0.5)
    conv_b = nrm(ks[24], (Dp, 2 * D_FF), 0.01)
    w_down = nrm(ks[25], (Dp, D_FF, D_MODEL), D_FF ** -0.5)
    return {"x": x, "c": c, "positions": positions, "w_ada": w_ada, "b_ada": b_ada,
            "norm_mix": norm_mix, "w_in": w_in, "ssm_log_dt": ssm_log_dt,
            "ssm_a_re": ssm_a_re, "ssm_a_im": ssm_a_im, "ssm_b_re": ssm_b_re,
            "ssm_b_im": ssm_b_im, "ssm_c_re": ssm_c_re, "ssm_c_im": ssm_c_im,
            "ssm_d": ssm_d, "ssm_w_glu": ssm_w_glu, "ssm_b_glu": ssm_b_glu,
            "q_norm": q_norm, "k_norm": k_norm, "out_norm_ssm": out_norm_ssm,
            "out_norm_attn": out_norm_attn, "w_out": w_out, "norm_ffn": norm_ffn,
            "w_up": w_up, "conv_w": conv_w, "conv_b": conv_b, "w_down": w_down}


def reference(x, c, positions, w_ada, b_ada, norm_mix, w_in, ssm_log_dt, ssm_a_re, ssm_a_im,
              ssm_b_re, ssm_b_im, ssm_c_re, ssm_c_im, ssm_d, ssm_w_glu, ssm_b_glu,
              q_norm, k_norm, out_norm_ssm, out_norm_attn, w_out, norm_ffn, w_up,
              conv_w, conv_b, w_down):
    bsz, L, _ = x.shape
    h = x.astype(jnp.float32)
    cs = jax.nn.silu(c.astype(jnp.float32))
    for l in range(DEPTH):
        mod = cs @ w_ada[l].astype(jnp.float32) + b_ada[l].astype(jnp.float32)
        sh1, sc1, g1, sh2, sc2, g2 = jnp.split(mod, 6, axis=-1)

        hn = _modulate(_rmsnorm(h, norm_mix[l]), sh1, sc1)
        proj = hn @ w_in[l].astype(jnp.float32)
        o = 0
        u = proj[..., o:o + D_SSM]; o += D_SSM
        q = proj[..., o:o + D_ATTN].reshape(bsz, L, N_HEADS, HEAD_DIM); o += D_ATTN
        k = proj[..., o:o + D_ATTN].reshape(bsz, L, N_HEADS, HEAD_DIM); o += D_ATTN
        v = proj[..., o:o + D_ATTN].reshape(bsz, L, N_HEADS, HEAD_DIM); o += D_ATTN
        qi = proj[..., o:o + IDX_HEADS * IDX_DIM].reshape(bsz, L, IDX_HEADS, IDX_DIM); o += IDX_HEADS * IDX_DIM
        ki = proj[..., o:o + IDX_DIM]; o += IDX_DIM
        wi = proj[..., o:o + IDX_HEADS] * (IDX_HEADS ** -0.5 * IDX_DIM ** -0.5)

        y_ssm = _s5_mixer(u, ssm_log_dt[l], ssm_a_re[l], ssm_a_im[l], ssm_b_re[l], ssm_b_im[l],
                          ssm_c_re[l], ssm_c_im[l], ssm_d[l], ssm_w_glu[l], ssm_b_glu[l])

        qr = _rope(_rmsnorm(q, q_norm[l]), positions)
        kr = _rope(_rmsnorm(k, k_norm[l]), positions)
        qir = _rope(qi, positions)
        kir = _rope(ki[:, :, None, :], positions)[:, :, 0, :]
        y_attn = _dsa_mixer(qr, kr, v, qir, kir, wi)

        y_mix = jnp.concatenate([_rmsnorm(y_ssm, out_norm_ssm[l]),
                                 _rmsnorm(y_attn, out_norm_attn[l])], axis=-1)
        h = h + g1[:, None, :] * (y_mix @ w_out[l].astype(jnp.float32))

        hn2 = _modulate(_rmsnorm(h, norm_ffn[l]), sh2, sc2)
        up = _causal_dwconv(hn2 @ w_up[l].astype(jnp.float32), conv_w[l], conv_b[l])
        gate, val = up[..., :D_FF], up[..., D_FF:]
        h = h + g2[:, None, :] * ((jax.nn.gelu(gate) * val) @ w_down[l].astype(jnp.float32))
    return h.astype(x.dtype)
```

```cpp
#include <hip/hip_runtime.h>
#include <hip/hip_cooperative_groups.h>
#include <cstdio>
#include <cstdint>
namespace cg = cooperative_groups;

typedef _Float16 h16;
typedef _Float16 h16x8 __attribute__((ext_vector_type(8)));
typedef _Float16 h16x4 __attribute__((ext_vector_type(4)));
typedef _Float16 h16x2 __attribute__((ext_vector_type(2)));
typedef float f32x16 __attribute__((ext_vector_type(16)));
typedef float f32x2 __attribute__((ext_vector_type(2)));
typedef unsigned u32x2_t __attribute__((ext_vector_type(2)));
#define LAS __attribute__((address_space(3)))

namespace pg8 {
#define PG8_LAS __attribute__((address_space(3)))
typedef float f32x4 __attribute__((ext_vector_type(4)));
typedef unsigned u32x4 __attribute__((ext_vector_type(4)));
constexpr int BM = 256, BK = 64, HALF = 128, HTB = HALF * BK * 2  , STAGE_BYTES = 8 * HTB, NXCD = 8, WGM = 8;

__host__ __device__ __forceinline__ int lds_byte(int r, int c) { const int st = (r >> 4) * 2 + (c >> 5), rr = r & 15, cc = c & 31, ob = rr * 64 + cc * 2; return st * 1024 + (ob ^ (((ob >> 9) & 1) << 5)); }
__host__ __device__ __forceinline__ void stage_rc(int b, int& R, int& C) { const int st = b / 1024, sb = b % 1024, swz = sb ^ (((sb >> 9) & 1) << 5); R = (st >> 1) * 16 + swz / 64; C = (st & 1) * 32 + (swz % 64) / 2; }
__host__ __device__ __forceinline__ int perm32(int rho) { const int n = rho >> 4, i = rho & 15; return 8 * (i >> 2) + 4 * n + (i & 3); }

struct Unit { int pm, pn; };
struct Gemm { const h16* A; const h16* Bt; int M, N, K, lda; };

struct StaticOrder {
    int nM, nN, nwg, G, c;
    __host__ __device__ void init(int M, int N, int G_, int c_) { nM = M / BM; nN = N / BM; nwg = nM * nN; G = G_; c = c_; }
    __host__ __device__ bool next(int i, Unit& u) const {
        const long L = (long)i * G + c; if (L >= nwg) return false;
        int wgid = (int)L; { const int q = nwg / NXCD, r = nwg % NXCD, xcd = wgid % NXCD, off = wgid / NXCD; wgid = (xcd < r ? xcd * (q + 1) : r * (q + 1) + (xcd - r) * q) + off; }
        const int nig = WGM * nN, gid = wgid / nig, fm = gid * WGM, gsz = (nM - fm) < WGM ? (nM - fm) : WGM;
        u.pm = fm + ((wgid % nig) % gsz); u.pn = (wgid % nig) / gsz; return true;
    }
    __device__ __forceinline__ void a_ready(const Unit&) const {}
    __device__ __forceinline__ void done(const Unit&) const {}
};

template <class Epi, class Sched, bool ALIGN_EPI = false, bool SP2 = false>
__device__ __forceinline__ void gemm_phase(PG8_LAS unsigned char* lds, const Gemm g, const Sched& S, const Epi& E) {
    int tid = threadIdx.x; asm volatile("" : "+v"(tid));
    const int wid = __builtin_amdgcn_readfirstlane(tid >> 6), lane = tid & 63, wr = wid >> 2, wc = wid & 3, fr = lane & 15, fq = lane >> 4;
    const int K = g.K, lda = g.lda, nt = K / BK;
    unsigned voffA[2], voffB[2];
#pragma unroll
    for (int i = 0; i < 2; ++i) { int R, C; stage_rc(tid * 16 + i * 8192, R, C); const int Rb = Epi::PERM ? ((R & ~31) + perm32(R & 31)) : R;
        voffA[i] = (unsigned)(R * lda + C) * 2u; voffB[i] = (unsigned)(Rb * K + C) * 2u; }
    const size_t kstep = (size_t)(BK * 2);
    const size_t hstepB = (size_t)HALF * K * 2, hstepA = (size_t)HALF * lda * 2;
    const size_t tstepA = 2 * hstepA, tstepB = 2 * hstepB;
    const unsigned ldsw = (unsigned)wid * 1024u;
    const int aoff = lds_byte(wr * 64 + fr, fq * 8), boff = lds_byte(wc * 32 + fr, fq * 8);
#define PG8_SA(b, h) (((b) * 2 + (h)) * HTB)
#define PG8_SB(b, h) ((4 + (b) * 2 + (h)) * HTB)
#define PG8_STAGE(bufoff, gbase, voff) do { _Pragma("unroll") for (int _i = 0; _i < 2; ++_i) \
        __builtin_amdgcn_global_load_lds((const unsigned*)((const char*)(gbase) + (voff)[_i]), (PG8_LAS unsigned*)(lds + (bufoff) + ldsw + _i * 8192), 16, 0, 0); } while (0)
#define PG8_LDA(dst, b, h) do { _Pragma("unroll") for (int m = 0; m < 4; ++m) _Pragma("unroll") for (int k = 0; k < 2; ++k) dst[m][k] = *(const PG8_LAS h16x8*)(lds + PG8_SA(b, h) + aoff + m * 2048 + k * 1024); } while (0)
#define PG8_LDB(dst, b, h) do { _Pragma("unroll") for (int n = 0; n < 2; ++n) _Pragma("unroll") for (int k = 0; k < 2; ++k) dst[n][k] = *(const PG8_LAS h16x8*)(lds + PG8_SB(b, h) + boff + n * 2048 + k * 1024); } while (0)
#define PG8_MMA(ai, bj, At, Bt) do { __builtin_amdgcn_s_setprio(1); _Pragma("unroll") for (int m = 0; m < 4; ++m) _Pragma("unroll") for (int n = 0; n < 2; ++n) _Pragma("unroll") for (int k = 0; k < 2; ++k) \
        acc[ai][bj][m][n] = __builtin_amdgcn_mfma_f32_16x16x32_f16(Bt[n][k], At[m][k], acc[ai][bj][m][n], 0, 0, 0); __builtin_amdgcn_s_setprio(0); } while (0)
#define PG8_WAIT_V(n) asm volatile("s_waitcnt vmcnt(" #n ")" ::: "memory")
#define PG8_WAIT_L(n) asm volatile("s_waitcnt lgkmcnt(" #n ")" ::: "memory")
#define PG8_BAR __builtin_amdgcn_s_barrier()
#define PG8_SCHED __builtin_amdgcn_sched_barrier(0)
    Unit cur, nxt; int ui = 0;
    if (!S.next(0, cur)) return;
    f32x4 acc[2][2][4][2];
#pragma unroll
    for (int a = 0; a < 2; ++a)
#pragma unroll
        for (int b = 0; b < 2; ++b)
#pragma unroll
            for (int m = 0; m < 4; ++m)
#pragma unroll
                for (int n = 0; n < 2; ++n) acc[a][b][m][n] = (f32x4){0.f, 0.f, 0.f, 0.f};
    h16x8 At[4][2], B0[2][2], B1[2][2];
    const char* cA = (const char*)g.A + (size_t)cur.pm * tstepA; const char* cB = (const char*)g.Bt + (size_t)cur.pn * tstepB;
    S.a_ready(cur);
    if constexpr (SP2) {
        PG8_STAGE(PG8_SB(0, 0), cB, voffB); PG8_STAGE(PG8_SB(0, 1), cB + hstepB, voffB); PG8_STAGE(PG8_SA(0, 0), cA, voffA); PG8_STAGE(PG8_SA(0, 1), cA + hstepA, voffA);
        if (wr == 1) PG8_BAR;
        PG8_WAIT_V(2); PG8_BAR;
        PG8_STAGE(PG8_SB(1, 0), cB + kstep, voffB); PG8_STAGE(PG8_SA(1, 0), cA + kstep, voffA); PG8_STAGE(PG8_SB(1, 1), cB + hstepB + kstep, voffB);
        PG8_WAIT_V(6); PG8_BAR;
    } else {
        PG8_STAGE(PG8_SB(0, 0), cB, voffB); PG8_STAGE(PG8_SA(0, 0), cA, voffA); PG8_STAGE(PG8_SB(0, 1), cB + hstepB, voffB); PG8_STAGE(PG8_SA(0, 1), cA + hstepA, voffA);
        if (wr == 1) PG8_BAR;
        PG8_WAIT_V(4); PG8_BAR;
        PG8_STAGE(PG8_SB(1, 0), cB + kstep, voffB); PG8_STAGE(PG8_SA(1, 0), cA + kstep, voffA); PG8_STAGE(PG8_SB(1, 1), cB + hstepB + kstep, voffB);
        PG8_WAIT_V(6); PG8_BAR;
    }
    for (;;) {
        const bool has_next = S.next(ui + 1, nxt);
        const char* nA = has_next ? (const char*)g.A + (size_t)nxt.pm * tstepA : cA; const char* nB = has_next ? (const char*)g.Bt + (size_t)nxt.pn * tstepB : cB;
        for (int t = 0; t < nt; t += 2) {
            if constexpr (Epi::MIDK_T >= 0) { if (t == Epi::MIDK_T) E.midk(acc, cur, wr, wc, fr, fq); }
            const bool last = (t == nt - 2);
            const char* a1 = cA + (size_t)(t + 1) * kstep;
            const char* a2 = last ? nA : cA + (size_t)(t + 2) * kstep; const char* b2 = last ? nB : cB + (size_t)(t + 2) * kstep;
            const char* a3 = a2 + kstep; const char* b3 = b2 + kstep;
            if (last && has_next) S.a_ready(nxt);
            if constexpr (SP2) {
            PG8_LDB(B0, 0, 0); PG8_LDB(B1, 0, 1); PG8_SCHED; PG8_LDA(At, 0, 0); PG8_STAGE(PG8_SA(1, 1), a1 + hstepA, voffA);
            PG8_WAIT_V(8); PG8_WAIT_L(0); PG8_BAR; PG8_MMA(0, 0, At, B0); PG8_MMA(0, 1, At, B1); PG8_BAR; PG8_SCHED;
            PG8_LDA(At, 0, 1); PG8_STAGE(PG8_SB(0, 0), b2, voffB); PG8_STAGE(PG8_SB(0, 1), b2 + hstepB, voffB); PG8_STAGE(PG8_SA(0, 0), a2, voffA);
            PG8_WAIT_V(8); PG8_WAIT_L(0); PG8_BAR; PG8_MMA(1, 0, At, B0); PG8_MMA(1, 1, At, B1); PG8_BAR; PG8_SCHED;
            PG8_LDB(B0, 1, 0); PG8_LDB(B1, 1, 1); PG8_SCHED; PG8_LDA(At, 1, 0); PG8_STAGE(PG8_SA(0, 1), a2 + hstepA, voffA);
            PG8_WAIT_V(8); PG8_WAIT_L(0); PG8_BAR; PG8_MMA(0, 0, At, B0); PG8_MMA(0, 1, At, B1); PG8_BAR; PG8_SCHED;
            PG8_LDA(At, 1, 1); PG8_STAGE(PG8_SB(1, 0), b3, voffB); PG8_STAGE(PG8_SB(1, 1), b3 + hstepB, voffB); PG8_STAGE(PG8_SA(1, 0), a3, voffA);
            PG8_WAIT_V(8); PG8_WAIT_L(0); PG8_BAR; PG8_MMA(1, 0, At, B0); PG8_MMA(1, 1, At, B1); PG8_BAR; PG8_SCHED;
            } else {
            PG8_LDB(B0, 0, 0); PG8_SCHED; PG8_LDA(At, 0, 0); PG8_STAGE(PG8_SA(1, 1), a1 + hstepA, voffA);
            PG8_WAIT_L(8); PG8_BAR; PG8_WAIT_L(0); PG8_MMA(0, 0, At, B0); PG8_BAR; PG8_SCHED;
            PG8_LDB(B1, 0, 1); PG8_STAGE(PG8_SB(0, 0), b2, voffB);
            PG8_BAR; PG8_WAIT_L(0); PG8_MMA(0, 1, At, B1); PG8_BAR;
            PG8_LDA(At, 0, 1); PG8_STAGE(PG8_SA(0, 0), a2, voffA);
            PG8_BAR; PG8_WAIT_L(0); PG8_MMA(1, 0, At, B0); PG8_BAR; PG8_SCHED;
            PG8_STAGE(PG8_SB(0, 1), b2 + hstepB, voffB);
            PG8_WAIT_V(6); PG8_BAR; PG8_MMA(1, 1, At, B1); PG8_BAR;
            PG8_LDB(B0, 1, 0); PG8_SCHED; PG8_LDA(At, 1, 0); PG8_STAGE(PG8_SA(0, 1), a2 + hstepA, voffA);
            PG8_WAIT_L(8); PG8_BAR; PG8_WAIT_L(0); PG8_MMA(0, 0, At, B0); PG8_BAR; PG8_SCHED;
            PG8_LDB(B1, 1, 1); PG8_STAGE(PG8_SB(1, 0), b3, voffB);
            PG8_BAR; PG8_WAIT_L(0); PG8_MMA(0, 1, At, B1); PG8_BAR;
            PG8_LDA(At, 1, 1); PG8_STAGE(PG8_SA(1, 0), a3, voffA);
            PG8_BAR; PG8_WAIT_L(0); PG8_MMA(1, 0, At, B0); PG8_BAR; PG8_SCHED;
            PG8_STAGE(PG8_SB(1, 1), b3 + hstepB, voffB);
            PG8_WAIT_V(6); PG8_BAR; PG8_MMA(1, 1, At, B1); PG8_BAR;
            }
        }
        if constexpr (ALIGN_EPI) { if (wr == 0) PG8_BAR; }
        if constexpr (!Epi::AFTER_DRAIN) { E(acc, cur, wr, wc, fr, fq); S.done(cur); }
        if (!has_next) break;
#pragma unroll
        for (int a = 0; a < 2; ++a)
#pragma unroll
            for (int b = 0; b < 2; ++b)
#pragma unroll
                for (int m = 0; m < 4; ++m)
#pragma unroll
                    for (int n = 0; n < 2; ++n) acc[a][b][m][n] = (f32x4){0.f, 0.f, 0.f, 0.f};
        cur = nxt; cA = nA; cB = nB; ++ui;
        if constexpr (ALIGN_EPI) { if (wr == 1) PG8_BAR; }
    }
    PG8_WAIT_V(0);
    if constexpr (!ALIGN_EPI) { if (wr == 0) PG8_BAR; }
    PG8_BAR;
    if constexpr (Epi::AFTER_DRAIN) { E.fused(acc, cur, wr, wc, fr, fq, lds, wid, lane); S.done(cur); }
#undef PG8_SA
#undef PG8_SB
#undef PG8_STAGE
#undef PG8_LDA
#undef PG8_LDB
#undef PG8_MMA
#undef PG8_WAIT_V
#undef PG8_WAIT_L
#undef PG8_BAR
#undef PG8_SCHED
}
}

constexpr int NB = 4, SL = 4096, DM = 1024, M = NB * SL;
constexpr int DSSM = 512, NG = 32, NCH = 16, NP = 64, NH = 8, HD = 64, DATT = 512;
constexpr int NPROJ = 2632, NPROJ_PAD = 2816, DFF = 2816, DUP = 2 * DFF, NMOD = 6 * DM;
constexpr int TOPK = 256;
constexpr float EPS = 1e-6f;
constexpr float QSCALE = 0.125f * 1.4426950408889634f;
constexpr float WI_SCALE = 0.04419417382415922f;
constexpr int NT = 512, NWAVES = 8;
constexpr int LDS_BYTES = 150528;

constexpr size_t MiB = 1u << 20;
constexpr size_t WS_CTL = 0, CTL_ZERO_BYTES = 1 * MiB;
constexpr size_t CTL_MOD_OFF = 512 * 1024;
constexpr size_t CTL_SSQS_OFF = 320 * 1024, CTL_SSQA_OFF = 384 * 1024;
constexpr size_t CTL_SSQ2_OFF = 256 * 1024;
constexpr size_t WS_WIN = 2 * MiB;
constexpr size_t WS_WGLU = WS_WIN + (size_t)NPROJ_PAD * DM * 2;
constexpr size_t WS_WOUT = 8 * MiB;
constexpr size_t WS_WUP = 10 * MiB;
constexpr size_t WS_WDOWN = 21 * MiB;
constexpr size_t WS_BIAS2 = 26 * MiB + 512 * 1024;
constexpr size_t WS_ROPE = 27 * MiB;
constexpr size_t WS_HN = 32 * MiB;
constexpr size_t WS_U = 64 * MiB, WS_Q = 80 * MiB, WS_K = 96 * MiB, WS_V = 112 * MiB, WS_QI = 128 * MiB;
constexpr size_t WS_KI = 144 * MiB;
constexpr size_t WS_KIF = 147 * MiB;
constexpr size_t WS_WI = 146 * MiB;
constexpr size_t WS_VT = 147 * MiB;
constexpr size_t WS_MASK = 163 * MiB;
constexpr size_t WS_YS = 171 * MiB;
constexpr size_t WS_YMIX = 187 * MiB;
constexpr size_t WS_YG = 219 * MiB;
constexpr size_t WS_YA = 235 * MiB;
constexpr size_t WS_WST = 219 * MiB;
constexpr size_t WS_WOT = 223 * MiB;
constexpr size_t WS_KT = 227 * MiB;
constexpr size_t WS_L32 = 227 * MiB + 512 * 1024;
constexpr size_t WS_UP = 64 * MiB;
constexpr size_t WS_HALO = 240 * MiB;
constexpr size_t WS_END = 256 * MiB;
static_assert(WS_Q == WS_U + 16 * MiB && WS_K == WS_U + 32 * MiB && WS_V == WS_U + 48 * MiB && WS_QI == WS_U + 64 * MiB, "EpiProj addresses U|Q|K|V|QI by tile pair");
static_assert(WS_UP + (size_t)M * DUP * 2 <= WS_END && WS_YA + (size_t)M * 512 * 2 <= WS_END, "ws map");
constexpr int CW_Q4 = 64;
constexpr int CW_BAR = 4096;

struct Params {
    const float *x, *c, *w_ada, *b_ada, *norm_mix, *w_in, *log_dt, *a_re, *a_im, *b_re, *b_im, *c_re, *c_im, *ssm_d, *w_glu, *b_glu,
                *q_norm, *k_norm, *on_ssm, *on_attn, *w_out, *norm_ffn, *w_up, *conv_w, *conv_b, *w_down;
    const int* positions;
    float* out;
    unsigned char* ws;
    unsigned long long use_cg_sync;
};

__device__ __forceinline__ unsigned pkh(float a, float b) { h16x2 v = {(h16)a, (h16)b}; return __builtin_bit_cast(unsigned, v); }
__device__ __forceinline__ float wave_sum(float v) {
#pragma unroll
    for (int o = 1; o < 64; o <<= 1) v += __shfl_xor(v, o);
    return v;
}
__device__ __forceinline__ float fexp2(float x) { return __builtin_amdgcn_exp2f(x); }
__device__ __forceinline__ float frcp(float x) { return __builtin_amdgcn_rcpf(x); }
__device__ __forceinline__ float sigmoidf_(float z) { return frcp(1.0f + fexp2(-1.4426950408889634f * z)); }
__device__ __forceinline__ float gelu_tanh(float x) {
    const float inner = 0.7978845608028654f * (x + 0.044715f * x * x * x);
    return x * frcp(1.0f + fexp2(-2.8853900817779268f * inner));
}
__device__ __forceinline__ int crow(int r, int hi) { return (r & 3) + 8 * (r >> 2) + 4 * hi; }
__device__ __forceinline__ void lds_barrier() { asm volatile("s_waitcnt lgkmcnt(0)\n\ts_barrier" ::: "memory"); }

using pg8::f32x4; using pg8::u32x4;
struct EpiStoreH {
    static constexpr bool PERM = true, AFTER_DRAIN = false; static constexpr int MIDK_T = -1;
    h16* O; int ldc;
    __device__ __forceinline__ void operator()(const f32x4 (&acc)[2][2][4][2], const pg8::Unit& u, int wr, int wc, int fr, int fq) const {
        const int row0 = u.pm * 256 + wr * 64 + fr, col0 = u.pn * 256 + wc * 32 + 8 * fq;
#pragma unroll
        for (int ai = 0; ai < 2; ++ai)
#pragma unroll
            for (int m = 0; m < 4; ++m) { h16* rowp = O + (size_t)(row0 + ai * 128 + m * 16) * ldc + col0;
#pragma unroll
                for (int bj = 0; bj < 2; ++bj) { const f32x4 v0 = acc[ai][bj][m][0], v1 = acc[ai][bj][m][1];
                    u32x4 w; w.x = pkh(v0[0], v0[1]); w.y = pkh(v0[2], v0[3]); w.z = pkh(v1[0], v1[1]); w.w = pkh(v1[2], v1[3]);
                    *(u32x4*)(rowp + bj * 128) = w; } }
    }
};
struct EpiProj {
    static constexpr bool PERM = true, AFTER_DRAIN = false; static constexpr int MIDK_T = -1;
    h16 *U, *Q, *K, *V, *QI, *KIF; float* WI; const float* RC; const float* RS; const float* qn; const float* kn;
    __device__ __forceinline__ void operator()(const f32x4 (&acc)[2][2][4][2], const pg8::Unit& u, int wr, int wc, int fr, int fq) const {
        int row0 = u.pm * 256 + wr * 64 + fr; asm volatile("" : "+v"(row0));
        const int pn = u.pn;
        if (pn < 2 || pn == 6 || pn == 7) {
            h16* dst = (h16*)((unsigned char*)U + (size_t)(pn >> 1) * (16u << 20)); const int cc0 = (pn & 1) * 256 + wc * 32 + 8 * fq;
#pragma unroll
            for (int bj = 0; bj < 2; ++bj)
#pragma unroll
                for (int ai = 0; ai < 2; ++ai)
#pragma unroll
                    for (int m = 0; m < 4; ++m) { const int row = row0 + ai * 128 + m * 16; const f32x4 v0 = acc[ai][bj][m][0], v1 = acc[ai][bj][m][1];
                        u32x4 w; w.x = pkh(v0[0], v0[1]); w.y = pkh(v0[2], v0[3]); w.z = pkh(v1[0], v1[1]); w.w = pkh(v1[2], v1[3]);
                        *(u32x4*)(dst + (size_t)row * 512 + cc0 + bj * 128) = w; }
            return;
        }
        if (pn == 10 && wc >= 2) return;
        if (pn == 10 && wc == 1) {
            if (fq == 0) {
#pragma unroll
                for (int ai = 0; ai < 2; ++ai)
#pragma unroll
                    for (int m = 0; m < 4; ++m) { float* wp = WI + (size_t)(row0 + ai * 128 + m * 16) * 8; *(f32x4*)wp = acc[ai][0][m][0] * WI_SCALE; *(f32x4*)(wp + 4) = acc[ai][0][m][1] * WI_SCALE; } }
            return;
        }
        const bool isq = (pn == 2 || pn == 3), isk = (pn == 4 || pn == 5);
        const float* nw = isk ? kn : qn; const float scale = isq ? QSCALE : 1.0f;
        f32x4 g0a = {1.f, 1.f, 1.f, 1.f}, g0b = g0a, g1a = g0a, g1b = g0a;
        if (isq || isk) { g0a = *(const f32x4*)(nw + 8 * fq); g0b = *(const f32x4*)(nw + 8 * fq + 4); g1a = *(const f32x4*)(nw + 32 + 8 * fq); g1b = *(const f32x4*)(nw + 32 + 8 * fq + 4); }
        h16* dst = (h16*)((unsigned char*)U + (size_t)(pn >> 1) * (16u << 20)); const int hcol = ((pn & 1) * 4 + wc) * 64 + 8 * fq;
#pragma unroll
        for (int ai = 0; ai < 2; ++ai)
#pragma unroll
            for (int m = 0; m < 4; ++m) {
                const int row = row0 + ai * 128 + m * 16;
                f32x4 x1a = acc[ai][0][m][0], x1b = acc[ai][0][m][1], x2a = acc[ai][1][m][0], x2b = acc[ai][1][m][1];
                if (isq || isk) {
                    float ss = 0.f;
#pragma unroll
                    for (int e = 0; e < 4; ++e) ss += x1a[e] * x1a[e] + x1b[e] * x1b[e] + x2a[e] * x2a[e] + x2b[e] * x2b[e];
                    ss += __shfl_xor(ss, 16); ss += __shfl_xor(ss, 32);
                    const float rstd = 1.0f / sqrtf(ss * (1.0f / 64.0f) + EPS);
                    x1a = x1a * rstd * g0a; x1b = x1b * rstd * g0b; x2a = x2a * rstd * g1a; x2b = x2b * rstd * g1b;
                }
                const f32x4 ca = *(const f32x4*)(RC + (size_t)row * 32 + 8 * fq), cb = *(const f32x4*)(RC + (size_t)row * 32 + 8 * fq + 4);
                const f32x4 sa = *(const f32x4*)(RS + (size_t)row * 32 + 8 * fq), sb = *(const f32x4*)(RS + (size_t)row * 32 + 8 * fq + 4);
                const f32x4 y1a = (x1a * ca - x2a * sa) * scale, y1b = (x1b * cb - x2b * sb) * scale, y2a = (x1a * sa + x2a * ca) * scale, y2b = (x1b * sb + x2b * cb) * scale;
                u32x4 w1, w2; w1.x = pkh(y1a[0], y1a[1]); w1.y = pkh(y1a[2], y1a[3]); w1.z = pkh(y1b[0], y1b[1]); w1.w = pkh(y1b[2], y1b[3]);
                w2.x = pkh(y2a[0], y2a[1]); w2.y = pkh(y2a[2], y2a[3]); w2.z = pkh(y2b[0], y2b[1]); w2.w = pkh(y2b[2], y2b[3]);
                if (pn == 10) {
                    const int bb = row / SL, key = row % SL; h16* kf = KIF + ((size_t)(bb * (SL / 16) + (key >> 4)) * 8) * 128 + (key & 15) * 8;
                    *(u32x4*)(kf + fq * 128) = w1; *(u32x4*)(kf + (4 + fq) * 128) = w2;
                } else { h16* rp = dst + (size_t)row * 512 + hcol; *(u32x4*)rp = w1; *(u32x4*)(rp + 32) = w2; }
            }
    }
};
struct EpiGlu {
    static constexpr bool PERM = true, AFTER_DRAIN = false; static constexpr int MIDK_T = -1;
    const h16* YS; h16* YO; const float* bias; float* SSQ;
    __device__ __forceinline__ void operator()(const f32x4 (&acc)[2][2][4][2], const pg8::Unit& u, int wr, int wc, int fr, int fq) const {
        const int row0 = u.pm * 256 + wr * 64 + fr, col0 = u.pn * 256 + wc * 32 + 8 * fq;
        float ss[2][4];
#pragma unroll
        for (int ai = 0; ai < 2; ++ai)
#pragma unroll
            for (int m = 0; m < 4; ++m) ss[ai][m] = 0.f;
#pragma unroll
        for (int bj = 0; bj < 2; ++bj) { const int c0 = col0 + bj * 128;
            const f32x4 b0 = *(const f32x4*)(bias + c0), b1 = *(const f32x4*)(bias + c0 + 4);
#pragma unroll
            for (int ai = 0; ai < 2; ++ai)
#pragma unroll
                for (int m = 0; m < 4; ++m) { const size_t row = (size_t)(row0 + ai * 128 + m * 16);
                    const h16x8 y = *(const h16x8*)(YS + row * 512 + c0); const f32x4 z0 = acc[ai][bj][m][0] + b0, z1 = acc[ai][bj][m][1] + b1;
                    float o[8];
#pragma unroll
                    for (int e = 0; e < 4; ++e) { o[e] = (float)y[e] * sigmoidf_(z0[e]); o[4 + e] = (float)y[4 + e] * sigmoidf_(z1[e]); }
#pragma unroll
                    for (int e = 0; e < 8; ++e) ss[ai][m] += o[e] * o[e];
                    u32x4 w; w.x = pkh(o[0], o[1]); w.y = pkh(o[2], o[3]); w.z = pkh(o[4], o[5]); w.w = pkh(o[6], o[7]);
                    *(u32x4*)(YO + row * DM + c0) = w; } }
#pragma unroll
        for (int ai = 0; ai < 2; ++ai)
#pragma unroll
            for (int m = 0; m < 4; ++m) { float v = ss[ai][m]; v += __shfl_xor(v, 16); v += __shfl_xor(v, 32);
                if (fq == 0) atomicAdd(SSQ + row0 + ai * 128 + m * 16, v); }
    }
};
struct EpiResid {
    static constexpr bool PERM = true, AFTER_DRAIN = false; static constexpr int MIDK_T = -1;
    const float* base; float* out; const float* gate;
    __device__ __forceinline__ void operator()(const f32x4 (&acc)[2][2][4][2], const pg8::Unit& u, int wr, int wc, int fr, int fq) const {
        const int row0 = u.pm * 256 + wr * 64 + fr, col0 = u.pn * 256 + wc * 32 + 8 * fq;
        const float* gp = gate + (size_t)((u.pm * 256) / SL) * NMOD;
#pragma unroll
        for (int bj = 0; bj < 2; ++bj) { const int c0 = col0 + bj * 128;
            const f32x4 g0 = *(const f32x4*)(gp + c0), g1 = *(const f32x4*)(gp + c0 + 4);
#pragma unroll
            for (int ai = 0; ai < 2; ++ai)
#pragma unroll
                for (int m = 0; m < 4; ++m) { const size_t off = (size_t)(row0 + ai * 128 + m * 16) * DM + c0;
                    const f32x4 x0 = *(const f32x4*)(base + off), x1 = *(const f32x4*)(base + off + 4);
                    *(f32x4*)(out + off) = x0 + g0 * acc[ai][bj][m][0]; *(f32x4*)(out + off + 4) = x1 + g1 * acc[ai][bj][m][1]; } }
    }
};

struct EpiResidNorm {
    static constexpr bool PERM = true, AFTER_DRAIN = false; static constexpr int MIDK_T = 8;
    const float* base; float* out; const float* gate; const float* nw; const float* sc; h16* A2; float* SSQ; const float* SSQS; const float* SSQA;
    __device__ __forceinline__ void midk(f32x4 (&acc)[2][2][4][2], const pg8::Unit& u, int wr, int wc, int fr, int fq) const {
        int row0 = u.pm * 256 + wr * 64 + fr; asm volatile("" : "+v"(row0));
#pragma unroll
        for (int ai = 0; ai < 2; ++ai)
#pragma unroll
            for (int m = 0; m < 4; ++m) { const int row = row0 + ai * 128 + m * 16;
                float f = sqrtf((SSQA[row] * (1.0f / 512.0f) + EPS) / (SSQS[row] * (1.0f / 512.0f) + EPS));
                asm volatile("" : "+v"(f) :: "memory");
#pragma unroll
                for (int bj = 0; bj < 2; ++bj) { acc[ai][bj][m][0] *= f; acc[ai][bj][m][1] *= f; }
                asm volatile("" : "+v"(acc[ai][0][m][0]), "+v"(acc[ai][0][m][1]), "+v"(acc[ai][1][m][0]), "+v"(acc[ai][1][m][1]) :: "memory"); }
    }
    __device__ __forceinline__ void operator()(const f32x4 (&acc)[2][2][4][2], const pg8::Unit& u, int wr, int wc, int fr, int fq) const {
        const int row0 = u.pm * 256 + wr * 64 + fr, col0 = u.pn * 256 + wc * 32 + 8 * fq;
        const size_t boff = (size_t)((u.pm * 256) / SL) * NMOD;
        float ss[2][4];
#pragma unroll
        for (int ai = 0; ai < 2; ++ai)
#pragma unroll
            for (int m = 0; m < 4; ++m) ss[ai][m] = 0.f;
#pragma unroll
        for (int bj = 0; bj < 2; ++bj) { const int c0 = col0 + bj * 128;
            const f32x4 g0 = *(const f32x4*)(gate + boff + c0), g1 = *(const f32x4*)(gate + boff + c0 + 4);
            const f32x4 s0 = (*(const f32x4*)(sc + boff + c0) + 1.0f) * *(const f32x4*)(nw + c0), s1 = (*(const f32x4*)(sc + boff + c0 + 4) + 1.0f) * *(const f32x4*)(nw + c0 + 4);
#pragma unroll
            for (int ai = 0; ai < 2; ++ai)
#pragma unroll
                for (int m = 0; m < 4; ++m) { const size_t off = (size_t)(row0 + ai * 128 + m * 16) * DM + c0;
                    const float ra = 1.0f / sqrtf(SSQA[row0 + ai * 128 + m * 16] * (1.0f / 512.0f) + EPS);
                    const f32x4 h0 = *(const f32x4*)(base + off) + g0 * (acc[ai][bj][m][0] * ra), h1 = *(const f32x4*)(base + off + 4) + g1 * (acc[ai][bj][m][1] * ra);
                    *(f32x4*)(out + off) = h0; *(f32x4*)(out + off + 4) = h1;
                    ss[ai][m] += (h0[0] * h0[0] + h0[1] * h0[1]) + (h0[2] * h0[2] + h0[3] * h0[3]) + (h1[0] * h1[0] + h1[1] * h1[1]) + (h1[2] * h1[2] + h1[3] * h1[3]);
                    const f32x4 a0 = h0 * s0, a1 = h1 * s1;
                    u32x4 w; w.x = pkh(a0[0], a0[1]); w.y = pkh(a0[2], a0[3]); w.z = pkh(a1[0], a1[1]); w.w = pkh(a1[2], a1[3]);
                    *(u32x4*)(A2 + off) = w; } }
#pragma unroll
        for (int ai = 0; ai < 2; ++ai)
#pragma unroll
            for (int m = 0; m < 4; ++m) { float v = ss[ai][m]; v += __shfl_xor(v, 16); v += __shfl_xor(v, 32);
                if (fq == 0) atomicAdd(SSQ + row0 + ai * 128 + m * 16, v); }
    }
};
struct EpiUp {
    static constexpr bool PERM = true, AFTER_DRAIN = false; static constexpr int MIDK_T = -1;
    h16* O; int ldc; const float* SSQ; const float* bias; h16* HALO;
    __device__ __forceinline__ void operator()(const f32x4 (&acc)[2][2][4][2], const pg8::Unit& u, int wr, int wc, int fr, int fq) const {
        const int row0 = u.pm * 256 + wr * 64 + fr, col0 = u.pn * 256 + wc * 32 + 8 * fq;
        const float* bp = bias + (size_t)((u.pm * 256) / SL) * ldc;
        f32x4 bv[2][2];
#pragma unroll
        for (int bj = 0; bj < 2; ++bj) { bv[bj][0] = *(const f32x4*)(bp + col0 + bj * 128); bv[bj][1] = *(const f32x4*)(bp + col0 + bj * 128 + 4); }
#pragma unroll
        for (int ai = 0; ai < 2; ++ai)
#pragma unroll
            for (int m = 0; m < 4; ++m) { const int row = row0 + ai * 128 + m * 16; const float rstd = 1.0f / sqrtf(SSQ[row] * (1.0f / DM) + EPS);
                h16* rowp = O + (size_t)row * ldc + col0;
#pragma unroll
                for (int bj = 0; bj < 2; ++bj) { const f32x4 v0 = acc[ai][bj][m][0] * rstd + bv[bj][0], v1 = acc[ai][bj][m][1] * rstd + bv[bj][1];
                    u32x4 w; w.x = pkh(v0[0], v0[1]); w.y = pkh(v0[2], v0[3]); w.z = pkh(v1[0], v1[1]); w.w = pkh(v1[2], v1[3]);
                    *(u32x4*)(rowp + bj * 128) = w;
                    if (m == 3 && fr >= 14) *(u32x4*)(HALO + ((size_t)(row >> 6) * 2 + (fr - 14)) * ldc + col0 + bj * 128) = w; } }
    }
};

__host__ __device__ __forceinline__ int win_prow(int n) {
    if (n < 512 || (n >= 1536 && n < 2048)) return n;
    if (n < 2560) { const int T = n & ~255, L = n & 255; return T + 128 * ((L >> 5) & 1) + 32 * (L >> 6) + (L & 31); }
    if (n < 2624) { const int d = n - 2560; return 2560 + 128 * (d >> 5) + (d & 31); }
    return 2560 + 32 + (n - 2624);
}
__device__ __forceinline__ void transpose_item(const float* W, int K, int N, h16* WT, LAS float* scr, int item, int lane, const float* ks0 = nullptr, const float* ks1 = nullptr, bool winperm = false) {
    const int nblk = (N + 31) / 32, kb = item / nblk, nb = item % nblk, k0 = 64 * kb, n0 = 32 * nb;
    const int nn = n0 + (lane & 31);
#pragma unroll 8
    for (int i = 0; i < 32; ++i) { const int kk = 2 * i + (lane >> 5); float v = (nn < N) ? W[(size_t)(k0 + kk) * N + nn] : 0.f;
        if (ks0) { const int kg = k0 + kk; v *= (kg < 512) ? ks0[kg] : ks1[kg - 512]; }
        scr[kk * 33 + (lane & 31)] = v; }
    asm volatile("s_waitcnt lgkmcnt(0)" ::: "memory");
    const int c = lane & 7;
#pragma unroll
    for (int j = 0; j < 4; ++j) { const int n = (lane >> 3) + 8 * j; const LAS float* s = scr + (8 * c) * 33 + n;
        u32x4 o; o.x = pkh(s[0 * 33], s[1 * 33]); o.y = pkh(s[2 * 33], s[3 * 33]); o.z = pkh(s[4 * 33], s[5 * 33]); o.w = pkh(s[6 * 33], s[7 * 33]);
        if (n0 + n < N) *(u32x4*)(WT + (size_t)(winperm ? win_prow(n0 + n) : (n0 + n)) * K + k0 + 8 * c) = o; }
    asm volatile("s_waitcnt lgkmcnt(0)" ::: "memory");
}

__device__ __forceinline__ void p0_prologue(const Params& p, LAS unsigned char* lds, int gw, int NGW, int wave, int lane) {
    unsigned char* ws = p.ws;
    LAS float* scr = (LAS float*)(lds + wave * 16384);
    constexpr int I_IN = (DM / 64) * ((NPROJ + 31) / 32), I_GLU = (DSSM / 64) * (DSSM / 32), I_OUT = (DM / 64) * (DM / 32), I_UP = (DM / 64) * (DUP / 32), I_DN = (DFF / 64) * (DM / 32);
    constexpr int NITEMS = I_IN + I_GLU + I_OUT + I_UP + I_DN;
    for (int it = gw; it < NITEMS; it += NGW) {
        int r = it;
        if (r < I_IN) { transpose_item(p.w_in, DM, NPROJ, (h16*)(ws + WS_WIN), scr, r, lane, nullptr, nullptr, true); continue; } r -= I_IN;
        if (r < I_GLU) { transpose_item(p.w_glu, DSSM, DSSM, (h16*)(ws + WS_WGLU), scr, r, lane); continue; } r -= I_GLU;
        if (r < I_OUT) { transpose_item(p.w_out, DM, DM, (h16*)(ws + WS_WOUT), scr, r, lane, p.on_ssm, p.on_attn); continue; } r -= I_OUT;
        if (r < I_UP) { transpose_item(p.w_up, DM, DUP, (h16*)(ws + WS_WUP), scr, r, lane); continue; } r -= I_UP;
        transpose_item(p.w_down, DFF, DM, (h16*)(ws + WS_WDOWN), scr, r, lane);
    }
    { const int nA = (2688 - 2600) * DM * 2 / 16, nB = (2816 - 2720) * DM * 2 / 16;
      u32x4* padA = (u32x4*)((h16*)(ws + WS_WIN) + (size_t)2600 * DM); u32x4* padB = (u32x4*)((h16*)(ws + WS_WIN) + (size_t)2720 * DM);
      for (int i = gw * 64 + lane; i < nA + nB; i += NGW * 64) { if (i < nA) padA[i] = (u32x4){0u, 0u, 0u, 0u}; else padB[i - nA] = (u32x4){0u, 0u, 0u, 0u}; } }
    float* MOD = (float*)(ws + WS_CTL + CTL_MOD_OFF);
    {
        LAS float* part = (LAS float*)(lds + 131072);
        for (int cgp = (int)blockIdx.x; cgp < NMOD / 32; cgp += (int)gridDim.x) {
            const int col = lane & 31, ks = lane >> 5, j = cgp * 32 + col, k0 = wave * 128;
            float a0 = 0.f, a1 = 0.f, a2 = 0.f, a3 = 0.f;
#pragma unroll 8
            for (int i = 0; i < 64; ++i) { const int k = k0 + 2 * i + ks; const float w = p.w_ada[(size_t)k * NMOD + j];
                const float c0 = p.c[k], c1 = p.c[DM + k], c2 = p.c[2 * DM + k], c3 = p.c[3 * DM + k];
                a0 += c0 * sigmoidf_(c0) * w; a1 += c1 * sigmoidf_(c1) * w; a2 += c2 * sigmoidf_(c2) * w; a3 += c3 * sigmoidf_(c3) * w; }
            a0 += __shfl_xor(a0, 32); a1 += __shfl_xor(a1, 32); a2 += __shfl_xor(a2, 32); a3 += __shfl_xor(a3, 32);
            if (ks == 0) { part[(wave * 4 + 0) * 32 + col] = a0; part[(wave * 4 + 1) * 32 + col] = a1; part[(wave * 4 + 2) * 32 + col] = a2; part[(wave * 4 + 3) * 32 + col] = a3; }
            __syncthreads();
            if (threadIdx.x < 128) { const int bq = threadIdx.x >> 5, cq = threadIdx.x & 31; float sum = p.b_ada[cgp * 32 + cq];
#pragma unroll
                for (int wv = 0; wv < 8; ++wv) sum += part[(wv * 4 + bq) * 32 + cq];
                MOD[(size_t)bq * NMOD + cgp * 32 + cq] = sum; }
            __syncthreads();
        }
    }
    float* RC = (float*)(ws + WS_ROPE); float* RS = RC + (size_t)M * 32;
    for (int i = gw * 64 + lane; i < M * 32; i += NGW * 64) { const int tok = i >> 5, f = i & 31;
        const float inv = exp2f(-(float)f * (13.287712379549449f / 32.0f));
        const float ang = (float)p.positions[tok] * inv;
        RC[i] = cosf(ang); RS[i] = sinf(ang); }
}

__device__ __forceinline__ void norm_mod_rows(const float* X, const float* gwt, const float* MOD, int sh_off, int sc_off, h16* OUT, int gw, int NGW, int lane) {
    for (int m = gw; m < M; m += NGW) {
        const int b = m / SL; const f32x4* xr = (const f32x4*)(X + (size_t)m * DM) + lane;
        f32x4 v[4]; float s = 0.f;
#pragma unroll
        for (int j = 0; j < 4; ++j) { v[j] = xr[64 * j]; s += (v[j][0] * v[j][0] + v[j][1] * v[j][1]) + (v[j][2] * v[j][2] + v[j][3] * v[j][3]); }
        const float rstd = 1.0f / sqrtf(wave_sum(s) * (1.0f / DM) + EPS);
        const float* shp = MOD + (size_t)b * NMOD + sh_off; const float* scp = MOD + (size_t)b * NMOD + sc_off;
#pragma unroll
        for (int j = 0; j < 4; ++j) { const int col = 4 * lane + 256 * j;
            const f32x4 g = *(const f32x4*)(gwt + col), sh = *(const f32x4*)(shp + col), sc = *(const f32x4*)(scp + col);
            const f32x4 o = v[j] * rstd * g * (sc + 1.0f) + sh;
            u32x2_t w; w.x = pkh(o[0], o[1]); w.y = pkh(o[2], o[3]);
            *(u32x2_t*)(OUT + (size_t)m * DM + col) = w; }
    }
}

__device__ __forceinline__ void bias2_rows(const Params& p, const float* MOD, int gw, int NGW, int lane) {
    const h16* WT = (const h16*)(p.ws + WS_WUP); float* B2 = (float*)(p.ws + WS_BIAS2);
    float sh[4][16];
#pragma unroll
    for (int b = 0; b < 4; ++b)
#pragma unroll
        for (int i = 0; i < 4; ++i) { const f32x4 v = *(const f32x4*)(MOD + (size_t)b * NMOD + 3 * DM + 16 * lane + 4 * i); sh[b][4 * i] = v[0]; sh[b][4 * i + 1] = v[1]; sh[b][4 * i + 2] = v[2]; sh[b][4 * i + 3] = v[3]; }
    for (int n = gw; n < DUP; n += NGW) {
        const h16x8 w0 = *(const h16x8*)(WT + (size_t)n * DM + 16 * lane), w1 = *(const h16x8*)(WT + (size_t)n * DM + 16 * lane + 8);
        float a[4] = {0.f, 0.f, 0.f, 0.f};
#pragma unroll
        for (int b = 0; b < 4; ++b) {
#pragma unroll
            for (int i = 0; i < 8; ++i) a[b] += sh[b][i] * (float)w0[i] + sh[b][8 + i] * (float)w1[i]; }
#pragma unroll
        for (int b = 0; b < 4; ++b) { const float t = wave_sum(a[b]); if (lane == 0) B2[(size_t)b * DUP + n] = t; }
    }
}

__device__ __forceinline__ void rope_norm8(h16* ptr, bool do_norm, const float* gw_, float scale, const f32x4 cs, const f32x4 sn) {
    const h16x4 lo = *(const h16x4*)ptr, hi = *(const h16x4*)(ptr + 32);
    float x1[4], x2[4]; float ss = 0.f;
#pragma unroll
    for (int i = 0; i < 4; ++i) { x1[i] = (float)lo[i]; x2[i] = (float)hi[i]; ss += x1[i] * x1[i] + x2[i] * x2[i]; }
    if (do_norm) {
        ss += __shfl_xor(ss, 1); ss += __shfl_xor(ss, 2); ss += __shfl_xor(ss, 4);
        const float rstd = 1.0f / sqrtf(ss * (1.0f / 64.0f) + EPS);
#pragma unroll
        for (int i = 0; i < 4; ++i) { x1[i] *= rstd * gw_[i]; x2[i] *= rstd * gw_[32 + i]; }
    }
    float y1[4], y2[4];
#pragma unroll
    for (int i = 0; i < 4; ++i) { y1[i] = (x1[i] * cs[i] - x2[i] * sn[i]) * scale; y2[i] = (x1[i] * sn[i] + x2[i] * cs[i]) * scale; }
    u32x2_t a, b; a.x = pkh(y1[0], y1[1]); a.y = pkh(y1[2], y1[3]); b.x = pkh(y2[0], y2[1]); b.y = pkh(y2[2], y2[3]);
    *(u32x2_t*)ptr = a; *(u32x2_t*)(ptr + 32) = b;
}
__device__ __forceinline__ void p3_token_pass(const Params& p, int gw, int NGW, int lane) {
    unsigned char* ws = p.ws;
    h16* Q = (h16*)(ws + WS_Q); h16* K = (h16*)(ws + WS_K); h16* V = (h16*)(ws + WS_V); h16* QI = (h16*)(ws + WS_QI); h16* KI = (h16*)(ws + WS_KI); h16* VT = (h16*)(ws + WS_VT);
    const float* RC = (const float*)(ws + WS_ROPE); const float* RS = RC + (size_t)M * 32;
    const int hh = lane >> 3, e = lane & 7;
    for (int tok = gw; tok < M; tok += NGW) {
        const f32x4 cs = *(const f32x4*)(RC + (size_t)tok * 32 + 4 * e), sn = *(const f32x4*)(RS + (size_t)tok * 32 + 4 * e);
        const size_t o = (size_t)tok * 512 + hh * 64 + 4 * e;
        rope_norm8(Q + o, true, p.q_norm + 4 * e, QSCALE, cs, sn);
        rope_norm8(K + o, true, p.k_norm + 4 * e, 1.0f, cs, sn);
        rope_norm8(QI + o, false, nullptr, 1.0f, cs, sn);
        if (hh == 0) {
            h16* kr = KI + (size_t)tok * 64 + 4 * e; rope_norm8(kr, false, nullptr, 1.0f, cs, sn);
            const int bb = tok / SL, key = tok % SL; h16* kf = (h16*)(ws + WS_KIF) + ((size_t)(bb * (SL / 32) + (key >> 5)) * 8) * 256 + (key & 31) * 8;
            const int sh0 = ((e >> 2) * 2 + ((e >> 1) & 1)) * 256 + 4 * (e & 1);
            *(u32x2_t*)(kf + sh0) = *(const u32x2_t*)kr; *(u32x2_t*)(kf + sh0 + 4 * 256) = *(const u32x2_t*)(kr + 32); }
    }
}


__device__ __forceinline__ f32x2 cmul(f32x2 a, f32x2 b) { return (f32x2){a.x * b.x - a.y * b.y, a.x * b.y + a.y * b.x}; }
__device__ __forceinline__ void s5_tables(const Params& p, int item, LAS unsigned char* lds) {
    const int tid = threadIdx.x, g = item >> 3, part = item & 7;
    LAS f32x2* pw = (LAS f32x2*)lds;
    LAS f32x2* bb = pw + 33 * 64;
    LAS f32x2* cc = bb + 64 * 16;
    h16* WST = (h16*)(p.ws + WS_WST) + (size_t)g * 128 * 512; h16* WOT = (h16*)(p.ws + WS_WOT) + (size_t)g * 512 * 128; h16* KT = (h16*)(p.ws + WS_KT) + (size_t)g * 32 * 256;
    float* L32 = (float*)(p.ws + WS_L32); float* DTT = L32 + 32 * 64 * 2;
    __syncthreads();
    if (tid < 64) {
        const int pp = tid; const float dt = expf(p.log_dt[g]);
        const float lr = p.a_re[g * 64 + pp], li = p.a_im[g * 64 + pp];
        const float mag = expf(lr * dt), ang = li * dt; const f32x2 lb = {mag * cosf(ang), mag * sinf(ang)};
        const float den = lr * lr + li * li, nr = lb.x - 1.0f, ni = lb.y;
        const float cr = (nr * lr + ni * li) / den / dt, ci = (ni * lr - nr * li) / den / dt;
        f32x2 z = {1.0f, 0.0f}; pw[pp] = z;
#pragma unroll 1
        for (int d = 1; d <= 32; ++d) { z = cmul(z, lb); pw[d * 64 + pp] = z; }
#pragma unroll
        for (int c = 0; c < 16; ++c) { const float br = p.b_re[(size_t)(g * 64 + pp) * 16 + c], bi = p.b_im[(size_t)(g * 64 + pp) * 16 + c];
            bb[pp * 16 + c] = (f32x2){cr * br - ci * bi, cr * bi + ci * br}; }
        if (part == 0) { L32[(g * 64 + pp) * 2] = z.x; L32[(g * 64 + pp) * 2 + 1] = z.y; if (pp == 0) DTT[g] = dt; }
    }
    for (int i = tid; i < 1024; i += NT) cc[i] = (f32x2){p.c_re[(size_t)g * 1024 + i], p.c_im[(size_t)g * 1024 + i]};
    __syncthreads();
    {
        const int idx = part * 512 + tid, col = idx >> 5, s_ = idx & 31, ri = (col >> 4) & 1, pq = 16 * (col >> 5) + (col & 15);
        const f32x2 z = pw[(31 - s_) * 64 + pq]; float v[16];
#pragma unroll
        for (int c = 0; c < 16; ++c) { const f32x2 w = cmul(z, bb[pq * 16 + c]); v[c] = ri ? w.y : w.x; }
        u32x4 o0, o1; o0.x = pkh(v[0], v[1]); o0.y = pkh(v[2], v[3]); o0.z = pkh(v[4], v[5]); o0.w = pkh(v[6], v[7]);
        o1.x = pkh(v[8], v[9]); o1.y = pkh(v[10], v[11]); o1.z = pkh(v[12], v[13]); o1.w = pkh(v[14], v[15]);
        h16* dst = WST + (size_t)col * 512 + 16 * s_; *(u32x4*)dst = o0; *(u32x4*)(dst + 8) = o1;
    }
#pragma unroll
    for (int i = 0; i < 2; ++i) {
        const int it = part * 1024 + tid + 512 * i, row = it >> 4, kc = it & 15, tau = row >> 4, c = row & 15, k0 = 8 * kc, ri = (k0 >> 4) & 1, pbase = 16 * (k0 >> 5) + (k0 & 15);
        float v[8];
#pragma unroll
        for (int j = 0; j < 8; ++j) { const f32x2 gq = cmul(cc[c * 64 + pbase + j], pw[(tau + 1) * 64 + pbase + j]); v[j] = ri ? -gq.y : gq.x; }
        u32x4 o; o.x = pkh(v[0], v[1]); o.y = pkh(v[2], v[3]); o.z = pkh(v[4], v[5]); o.w = pkh(v[6], v[7]);
        *(u32x4*)(WOT + (size_t)row * 128 + k0) = o;
    }
#pragma unroll
    for (int i = 0; i < 2; ++i) {
        const int e = part * 1024 + tid + 512 * i, d = e >> 8, c = (e >> 4) & 15, c2 = e & 15; float acc = 0.f;
#pragma unroll 4
        for (int q = 0; q < 64; ++q) { const f32x2 t1 = cmul(cc[c * 64 + q], pw[d * 64 + q]); const f32x2 b2 = bb[q * 16 + c2]; acc += t1.x * b2.x - t1.y * b2.y; }
        KT[e] = (h16)acc;
    }
    __syncthreads();
}

__device__ __forceinline__ void s5_unit_mfma(const Params& p, int bg, LAS unsigned char* lds) {
    int tid = threadIdx.x; asm volatile("" : "+v"(tid));
    const int lane = tid & 63, wave = __builtin_amdgcn_readfirstlane(tid >> 6), r = lane & 31, hi = lane >> 5, b = bg >> 5, g = bg & 31;
    constexpr int U_OFF = 0, KT_OFF = 33280, S_OFF = 49664, X_OFF = 82432, XPITCH = 136;
    LAS unsigned char* U_s = lds + U_OFF; LAS h16* KT_s = (LAS h16*)(lds + KT_OFF); LAS float* S_s = (LAS float*)(lds + S_OFF); LAS h16* X_s = (LAS h16*)(lds + X_OFF);
    const h16* U = (const h16*)(p.ws + WS_U); h16* YS = (h16*)(p.ws + WS_YS);
    const h16* WST = (const h16*)(p.ws + WS_WST) + (size_t)g * 128 * 512; const h16* WOT = (const h16*)(p.ws + WS_WOT) + (size_t)g * 512 * 128; const h16* KT = (const h16*)(p.ws + WS_KT) + (size_t)g * 32 * 256;
    const float* L32 = (const float*)(p.ws + WS_L32); const float dt = L32[32 * 64 * 2 + g];
    lds_barrier();
    const int qA = wave & 3, khA = wave >> 2;
    for (int i = tid; i < 1024; i += NT) *(LAS u32x4*)(KT_s + 8 * i) = *(const u32x4*)(KT + 8 * i);
    const float dsk = p.ssm_d[g * 16 + (r & 15)];
    float l32r = 0.f, l32i = 0.f, xr = 0.f, xi = 0.f;
    if (tid < 64) { l32r = L32[(g * 64 + tid) * 2]; l32i = L32[(g * 64 + tid) * 2 + 1]; }
    const int ufrag_off = r * 1040 + 16 * hi;
    for (int cb = 0; cb < 4; ++cb) {
        lds_barrier();
#pragma unroll
        for (int k = 0; k < 4; ++k) { const int i = tid + 512 * k, t = i >> 1, hf = i & 1;
            *(LAS u32x4*)(U_s + t * 32 + (t >> 5) * 16 + 16 * hf) = *(const u32x4*)(U + (size_t)(b * SL + 1024 * cb + t) * 512 + 16 * g + 8 * hf); }
        lds_barrier();
        {
            h16x8 wst[16];
#pragma unroll
            for (int i = 0; i < 16; ++i) wst[i] = *(const h16x8*)(WST + (size_t)(32 * qA + r) * 512 + 16 * (16 * khA + i) + 8 * hi);
            f32x16 acc = {};
#pragma unroll
            for (int i = 0; i < 16; ++i) { const h16x8 a = *(const LAS h16x8*)(U_s + ufrag_off + (16 * khA + i) * 32);
                acc = __builtin_amdgcn_mfma_f32_32x32x16_f16(a, wst[i], acc, 0, 0, 0); }
#pragma unroll
            for (int rg = 0; rg < 16; ++rg) S_s[(khA * 32 + crow(rg, hi)) * 128 + 32 * qA + r] = acc[rg];
        }
        lds_barrier();
        if (tid < 64) {
            const int sre = 32 * (tid >> 4) + (tid & 15), sim = sre + 16;
#pragma unroll 4
            for (int ch = 0; ch < 32; ++ch) {
                const float sr = S_s[ch * 128 + sre] + S_s[(32 + ch) * 128 + sre], si = S_s[ch * 128 + sim] + S_s[(32 + ch) * 128 + sim];
                X_s[ch * XPITCH + sre] = (h16)xr; X_s[ch * XPITCH + sim] = (h16)xi;
                const float nxr = l32r * xr - l32i * xi + sr, nxi = l32r * xi + l32i * xr + si; xr = nxr; xi = nxi;
            }
        }
        lds_barrier();
#pragma unroll 1
        for (int nbi = 0; nbi < 2; ++nbi) {
            const int n = nbi ? 15 - wave : wave, tau = 2 * n + (r >> 4), c = r & 15;
            h16x8 wot[8];
#pragma unroll
            for (int ks = 0; ks < 8; ++ks) wot[ks] = *(const h16x8*)(WOT + (size_t)(32 * n + r) * 128 + 16 * ks + 8 * hi);
            f32x16 acc = {};
#pragma unroll 2
            for (int s_ = 0; s_ <= 2 * n + 1; ++s_) {
                const h16x8 a = *(const LAS h16x8*)(U_s + ufrag_off + s_ * 32);
                const int d = tau - s_; const int dd = d < 0 ? 0 : d;
                h16x8 bq = *(const LAS h16x8*)(KT_s + (dd * 16 + c) * 16 + 8 * hi);
                if (d < 0) bq = (h16x8){};
                acc = __builtin_amdgcn_mfma_f32_32x32x16_f16(a, bq, acc, 0, 0, 0);
            }
#pragma unroll
            for (int ks = 0; ks < 8; ++ks) { const h16x8 a = *(const LAS h16x8*)(X_s + r * XPITCH + 16 * ks + 8 * hi);
                acc = __builtin_amdgcn_mfma_f32_32x32x16_f16(a, wot[ks], acc, 0, 0, 0); }
#pragma unroll
            for (int rg = 0; rg < 16; ++rg) { const int ch = crow(rg, hi), t = 32 * ch + tau;
                const float uval = (float)*(const LAS h16*)(U_s + t * 32 + ch * 16 + 2 * c);
                const float y = dt * acc[rg] + dsk * uval;
                YS[(size_t)(b * SL + 1024 * cb + t) * 512 + 16 * g + c] = (h16)gelu_tanh(y); }
        }
    }
    lds_barrier();
}

__device__ __forceinline__ void s5_unit(const Params& p, int bg, LAS unsigned char* lds) {
    const int tid = threadIdx.x, b = bg >> 5, g = bg & 31;
    LAS float* u_s = (LAS float*)lds;
    LAS f32x2* x_s = (LAS f32x2*)(lds + 4096);
    const h16* U = (const h16*)(p.ws + WS_U); h16* YS = (h16*)(p.ws + WS_YS);
    const int pp = tid & 63, tq = tid >> 6;
    const float dt = expf(p.log_dt[g]);
    const float lr = p.a_re[g * 64 + pp], li = p.a_im[g * 64 + pp];
    const float mag = expf(lr * dt), ang = li * dt;
    const float lb_re = mag * cosf(ang), lb_im = mag * sinf(ang);
    const float den = lr * lr + li * li, nr = lb_re - 1.0f, ni = lb_im;
    const float coef_re = (nr * lr + ni * li) / den, coef_im = (ni * lr - nr * li) / den;
    float bbr[16], bbi[16];
#pragma unroll
    for (int c = 0; c < 16; ++c) { const float br = p.b_re[(size_t)(g * 64 + pp) * 16 + c], bi = p.b_im[(size_t)(g * 64 + pp) * 16 + c];
        bbr[c] = coef_re * br - coef_im * bi; bbi[c] = coef_re * bi + coef_im * br; }
    const int oc = tid & 15, ph = (tid >> 4) & 1, tt = tid >> 5;
    float cre[32], cim[32];
#pragma unroll
    for (int j = 0; j < 32; ++j) { cre[j] = p.c_re[(size_t)(g * 16 + oc) * 64 + ph * 32 + j]; cim[j] = p.c_im[(size_t)(g * 16 + oc) * 64 + ph * 32 + j]; }
    const float dsk = p.ssm_d[g * 16 + oc];
    float xr = 0.f, xi = 0.f;
    for (int chunk = 0; chunk < SL / 64; ++chunk) {
        const size_t row0 = (size_t)b * SL + chunk * 64;
        __syncthreads();
        { const int idx = tid * 2, t = idx >> 4, c = idx & 15; const h16x2 uv = *(const h16x2*)(U + (row0 + t) * 512 + g * 16 + c); u_s[idx] = (float)uv[0]; u_s[idx + 1] = (float)uv[1]; }
        __syncthreads();
#pragma unroll
        for (int i = 0; i < 8; ++i) { const int t = tq + 8 * i; float re = 0.f, im = 0.f;
#pragma unroll
            for (int c4 = 0; c4 < 4; ++c4) { const f32x4 uu = *(const LAS f32x4*)(u_s + t * 16 + 4 * c4);
#pragma unroll
                for (int e = 0; e < 4; ++e) { re += bbr[4 * c4 + e] * uu[e]; im += bbi[4 * c4 + e] * uu[e]; } }
            x_s[t * 64 + pp] = (f32x2){re, im}; }
        __syncthreads();
        if (tid < 64) {
#pragma unroll 8
            for (int t = 0; t < 64; ++t) { const f32x2 v = x_s[t * 64 + pp];
                const float nxr = lb_re * xr - lb_im * xi + v.x, nxi = lb_re * xi + lb_im * xr + v.y; xr = nxr; xi = nxi; x_s[t * 64 + pp] = (f32x2){xr, xi}; }
        }
        __syncthreads();
#pragma unroll
        for (int i = 0; i < 4; ++i) { const int t = tt + 16 * i; float acc = 0.f;
#pragma unroll
            for (int j = 0; j < 32; j += 2) { const f32x4 xx = *(const LAS f32x4*)(x_s + t * 64 + ph * 32 + j);
                acc += xx[0] * cre[j] - xx[1] * cim[j] + xx[2] * cre[j + 1] - xx[3] * cim[j + 1]; }
            acc += __shfl_xor(acc, 16);
            if (ph == 0) { const float y = acc + dsk * u_s[t * 16 + oc]; YS[(row0 + t) * 512 + g * 16 + oc] = (h16)gelu_tanh(y); } }
    }
    __syncthreads();
}

template <int CTRL> __device__ __forceinline__ int dppi(int v) { return __builtin_amdgcn_update_dpp(0, v, CTRL, 0xF, 0xF, true); }
template <int CTRL> __device__ __forceinline__ float dppf(float v) { return __int_as_float(__builtin_amdgcn_update_dpp(0, __float_as_int(v), CTRL, 0xF, 0xF, true)); }
__device__ __forceinline__ float row16_min(float v) { v = fminf(v, dppf<0xB1>(v)); v = fminf(v, dppf<0x4E>(v)); v = fminf(v, dppf<0x141>(v)); return fminf(v, dppf<0x140>(v)); }
__device__ __forceinline__ float row16_max(float v) { v = fmaxf(v, dppf<0xB1>(v)); v = fmaxf(v, dppf<0x4E>(v)); v = fmaxf(v, dppf<0x141>(v)); return fmaxf(v, dppf<0x140>(v)); }
__device__ __forceinline__ int wave_incl_scan(int v) {
    v += dppi<0x111>(v); v += dppi<0x112>(v); v += dppi<0x114>(v); v += dppi<0x118>(v);
    v += __builtin_amdgcn_update_dpp(0, v, 0x142, 0xA, 0xF, false);
    v += __builtin_amdgcn_update_dpp(0, v, 0x143, 0xC, 0xF, false);
    return v;
}
typedef short s16x2_t __attribute__((ext_vector_type(2)));
typedef float f32x2_t_ __attribute__((ext_vector_type(2)));
__device__ __forceinline__ unsigned pkh2(float a, float b) { const f32x2_t_ f = {a, b}; return __builtin_bit_cast(unsigned, __builtin_convertvector(f, h16x2)); }
__device__ __forceinline__ unsigned relu_pkh(float a, float b) { s16x2_t q = __builtin_bit_cast(s16x2_t, pkh2(a, b)); q = __builtin_elementwise_max(q, (s16x2_t){0, 0}); return __builtin_bit_cast(unsigned, q); }
__device__ __forceinline__ unsigned okey2(unsigned p) { s16x2_t sg = __builtin_bit_cast(s16x2_t, p); sg = sg >> (s16x2_t){15, 15}; return p ^ (__builtin_bit_cast(unsigned, sg) | 0x80008000u); }
__device__ __forceinline__ unsigned pk_subsat_u16(unsigned a, unsigned b) { unsigned r_; asm("v_pk_sub_u16 %0, %1, %2 clamp" : "=v"(r_) : "v"(a), "v"(b)); return r_; }
__device__ __forceinline__ unsigned pk_min_u16(unsigned a, unsigned b) { unsigned r_; asm("v_pk_min_u16 %0, %1, %2" : "=v"(r_) : "v"(a), "v"(b)); return r_; }
__device__ __forceinline__ unsigned okey(float f) { const unsigned u = __float_as_uint(f); return (u & 0x80000000u) ? ~u : (u | 0x80000000u); }
__device__ __forceinline__ int hist_pick(const LAS unsigned* hist, int lane, int& need, int& cnt) {
    const int base = 4 * (63 - lane);
    const pg8::u32x4 hv = *(const LAS pg8::u32x4*)(hist + base);
    const int cl = (int)(hv.x + hv.y + hv.z + hv.w);
    const int P = wave_incl_scan(cl);
    const unsigned long long bal = __ballot(P >= need);
    const int Lsel = __builtin_amdgcn_readfirstlane(__ffsll((long long)bal) - 1);
    const int above = __builtin_amdgcn_readlane(P - cl, Lsel);
    const int g3 = __builtin_amdgcn_readlane((int)hv.w, Lsel), g2 = __builtin_amdgcn_readlane((int)hv.z, Lsel), g1 = __builtin_amdgcn_readlane((int)hv.y, Lsel), g0 = __builtin_amdgcn_readlane((int)hv.x, Lsel);
    int cum = above, digit;
    if (cum + g3 >= need) { digit = 3; cnt = g3; } else { cum += g3;
        if (cum + g2 >= need) { digit = 2; cnt = g2; } else { cum += g2;
            if (cum + g1 >= need) { digit = 1; cnt = g1; } else { cum += g1; digit = 0; cnt = g0; } } }
    need -= cum;
    return 4 * (63 - Lsel) + digit;
}
struct TilePrefetch { h16x8 qa[2][4]; f32x4 wv; int tok0; };
__device__ __forceinline__ int queue_tok0(int it) { const int idx = it - NB * NG, pblk = (SL / 8 - 1) - (idx >> 2), bb = idx & 3; return bb * SL + 8 * pblk; }
__device__ __forceinline__ void select_tile(const Params& p, int tok0, LAS unsigned char* lds, TilePrefetch& pf, int nxt) {
    int tid = threadIdx.x; asm volatile("" : "+v"(tid));
    const int lane = tid & 63, wave = __builtin_amdgcn_readfirstlane(tid >> 6), r = lane & 31, hi = lane >> 5;
    LAS float* sc = (LAS float*)lds;
    LAS unsigned* hist = (LAS unsigned*)(lds + 131072) + wave * 448;
    LAS unsigned* rng = (LAS unsigned*)(lds + 131072 + 8 * 448 * 4);
    const h16* QI = (const h16*)(p.ws + WS_QI); const h16* KIF = (const h16*)(p.ws + WS_KIF); const float* WI = (const float*)(p.ws + WS_WI);
    unsigned char* MTB = (unsigned char*)(p.ws + WS_MASK);
    const int b = tok0 >> 12, t0 = tok0 & (SL - 1), nk = t0 + 8, nsub = (nk > TOPK) ? ((nk + 31) >> 5) : 0;
    if (tid < 8) { rng[2 * tid] = 0xFFFFFFFFu; rng[2 * tid + 1] = 0u; }
    h16x8 (&qa)[2][4] = pf.qa;
    h16x8 wfr[2][2];
    if (nsub > 0) {
        if (pf.tok0 != tok0) {
#pragma unroll
            for (int rb = 0; rb < 2; ++rb) {
                const h16* qp = QI + (size_t)(tok0 + 4 * rb + (r >> 3)) * 512 + (r & 7) * 64 + 8 * hi;
#pragma unroll
                for (int s = 0; s < 4; ++s) qa[rb][s] = *(const h16x8*)(qp + 16 * s);
            }
            pf.wv = (f32x4){0.f, 0.f, 0.f, 0.f};
            if (r < 8) pf.wv = *(const f32x4*)(WI + (size_t)(tok0 + r) * 8 + 4 * hi);
        }
        const f32x4 wv = pf.wv;
#pragma unroll
        for (int rb = 0; rb < 2; ++rb)
#pragma unroll
            for (int s = 0; s < 2; ++s)
#pragma unroll
                for (int j = 0; j < 8; ++j) wfr[rb][s][j] = (r == 4 * rb + 2 * s + (j >> 2)) ? (h16)wv[j & 3] : (h16)0.f;
    }
    lds_barrier();
    float mn[4], mx[4];
#pragma unroll
    for (int i = 0; i < 4; ++i) { mn[i] = INFINITY; mx[i] = -INFINITY; }
    const int nmine = (nsub > wave) ? ((nsub - wave + NWAVES - 1) / NWAVES) : 0;
    const int klast = (nmine > 0) ? (nmine - 1) : 0;
    const h16* kbase = KIF + ((size_t)(b * (SL / 32)) * 8 + hi) * 256 + r * 8;
#define KLOAD(dst, kk) do { const int sub_ = wave + NWAVES * min((kk), klast); const h16* kp_ = kbase + (size_t)sub_ * 2048; \
        _Pragma("unroll") for (int s_ = 0; s_ < 4; ++s_) dst[s_] = *(const h16x8*)(kp_ + 512 * s_); } while (0)
#define QK(accv, kf) do { _Pragma("unroll") for (int rb_ = 0; rb_ < 2; ++rb_) accv[rb_] = (f32x16){}; \
        _Pragma("unroll") for (int s_ = 0; s_ < 4; ++s_) _Pragma("unroll") for (int rb_ = 0; rb_ < 2; ++rb_) accv[rb_] = __builtin_amdgcn_mfma_f32_32x32x16_f16(qa[rb_][s_], kf[s_], accv[rb_], 0, 0, 0); } while (0)
#define FINISH(accv, kk) do { f32x16 Y_ = {}; \
        _Pragma("unroll") for (int s_ = 0; s_ < 2; ++s_) _Pragma("unroll") for (int rb_ = 0; rb_ < 2; ++rb_) { pg8::u32x4 x_; \
            x_.x = relu_pkh(accv[rb_][8 * s_], accv[rb_][8 * s_ + 1]); x_.y = relu_pkh(accv[rb_][8 * s_ + 2], accv[rb_][8 * s_ + 3]); x_.z = relu_pkh(accv[rb_][8 * s_ + 4], accv[rb_][8 * s_ + 5]); x_.w = relu_pkh(accv[rb_][8 * s_ + 6], accv[rb_][8 * s_ + 7]); \
            Y_ = __builtin_amdgcn_mfma_f32_32x32x16_f16(wfr[rb_][s_], __builtin_bit_cast(h16x8, x_), Y_, 0, 0, 0); } \
        const int key0_ = 32 * (wave + NWAVES * min((kk), klast)); \
        _Pragma("unroll") for (int q_ = 0; q_ < 4; ++q_) { const float v_ = Y_[q_] + 0.0f; \
            sc[(4 * hi + q_) * 4096 + key0_ + r] = v_; mn[q_] = fminf(mn[q_], v_); mx[q_] = fmaxf(mx[q_], v_); } } while (0)
    if (nmine > 0) {
        h16x8 kA[4], kB[4]; f32x16 accA[2], accB[2];
        KLOAD(kA, 0); KLOAD(kB, 1);
        QK(accA, kA); KLOAD(kA, 2);
        for (int k = 0; k < nmine; k += 2) {
            QK(accB, kB); KLOAD(kB, k + 3);
            FINISH(accA, k);
            QK(accA, kA); KLOAD(kA, k + 4);
            FINISH(accB, k + 1);
        }
    }
#undef KLOAD
#undef QK
#undef FINISH
    if (nsub > 0) {
#pragma unroll
        for (int i = 0; i < 4; ++i) {
            const float rmn = row16_min(mn[i]), rmx = row16_max(mx[i]);
            if ((lane & 15) == 0 && rmx >= rmn) { const int tl = 4 * hi + i;
                __hip_atomic_fetch_min(&rng[2 * tl], okey(rmn), __ATOMIC_RELAXED, __HIP_MEMORY_SCOPE_WORKGROUP);
                __hip_atomic_fetch_max(&rng[2 * tl + 1], okey(rmx), __ATOMIC_RELAXED, __HIP_MEMORY_SCOPE_WORKGROUP); }
        }
    }
    LAS int* slot2 = (LAS int*)(lds + LDS_BYTES - 56);
    if (tid == 0) *slot2 = nxt;
    lds_barrier();
    {
        const int it2 = *slot2; pf.tok0 = -1;
        if (it2 >= NB * NG && it2 < NB * NG + M / 8) { const int tk = queue_tok0(it2);
            if ((tk & (SL - 1)) + 8 > TOPK) { pf.tok0 = tk;
#pragma unroll
                for (int rb = 0; rb < 2; ++rb) { const h16* qp = QI + (size_t)(tk + 4 * rb + (r >> 3)) * 512 + (r & 7) * 64 + 8 * hi;
#pragma unroll
                    for (int s = 0; s < 4; ++s) pf.qa[rb][s] = *(const h16x8*)(qp + 16 * s); }
                pf.wv = (f32x4){0.f, 0.f, 0.f, 0.f};
                if (r < 8) pf.wv = *(const f32x4*)(WI + (size_t)(tk + r) * 8 + 4 * hi); } }
    }
    {
        const int t = t0 + wave, n = t + 1;
        const LAS float* row = sc + wave * 4096;
        LAS unsigned* mrow = (LAS unsigned*)(sc + wave * 4096);
        if (n <= TOPK) {
#pragma unroll
            for (int k = 0; k < 2; ++k) { const int wq = lane + 64 * k, lo = 32 * wq; unsigned wd = 0u;
                if (t >= lo + 31) wd = 0xFFFFFFFFu; else if (t >= lo) wd = (1u << (t - lo + 1)) - 1u;
                mrow[wq] = wd; }
        } else {
            const int n4 = (n + 255) >> 8, nfull = n >> 8;
            LAS float* cv = (LAS float*)(hist + 320); LAS int* ci = (LAS int*)(hist + 384);
            bool done = false;
            const unsigned kmn = rng[2 * wave], kmx = rng[2 * wave + 1];
            const float vmin = __uint_as_float((kmn & 0x80000000u) ? (kmn & 0x7FFFFFFFu) : ~kmn), vmax = __uint_as_float((kmx & 0x80000000u) ? (kmx & 0x7FFFFFFFu) : ~kmx);
            const float range = vmax - vmin;
            if (range > 0.f && range < 3.0e38f) {
                const float fs = 256.0f / range, fo = -vmin * fs;
                int need = TOPK, cnt = 0;
                for (int i = lane; i < 258; i += 64) hist[i] = 0u;
                asm volatile("s_waitcnt lgkmcnt(0)" ::: "memory");
#pragma unroll 4
                for (int j = 0; j < nfull; ++j) { const f32x4 v = *(const LAS f32x4*)(row + 256 * j + 4 * lane);
#pragma unroll
                    for (int e = 0; e < 4; ++e) { const int q1 = min(255, max(0, (int)fmaf(v[e], fs, fo)));
                        __hip_atomic_fetch_add(&hist[q1], 1u, __ATOMIC_RELAXED, __HIP_MEMORY_SCOPE_WORKGROUP); } }
                if (nfull < n4) { const int base = 256 * nfull + 4 * lane; const f32x4 v = *(const LAS f32x4*)(row + base);
#pragma unroll
                    for (int e = 0; e < 4; ++e) { int q1 = min(255, max(0, (int)fmaf(v[e], fs, fo))); q1 = (base + e < n) ? q1 : 256;
                        __hip_atomic_fetch_add(&hist[q1], 1u, __ATOMIC_RELAXED, __HIP_MEMORY_SCOPE_WORKGROUP); } }
                asm volatile("s_waitcnt lgkmcnt(0)" ::: "memory");
                const int b1 = hist_pick(hist, lane, need, cnt);
                int b2 = -1;
                if (cnt > 64) {
                    for (int i = lane; i < 257; i += 64) hist[i] = 0u;
                    asm volatile("s_waitcnt lgkmcnt(0)" ::: "memory");
                    for (int j = 0; j < n4; ++j) { const int base = 256 * j + 4 * lane; const f32x4 v = *(const LAS f32x4*)(row + base);
#pragma unroll
                        for (int e = 0; e < 4; ++e) { const float f = fmaf(v[e], fs, fo); const int q1 = min(255, max(0, (int)f));
                            if (base + e < n && q1 == b1) { const int q2 = min(255, max(0, (int)((f - (float)q1) * 256.0f)));
                                __hip_atomic_fetch_add(&hist[q2], 1u, __ATOMIC_RELAXED, __HIP_MEMORY_SCOPE_WORKGROUP); } } }
                    asm volatile("s_waitcnt lgkmcnt(0)" ::: "memory");
                    b2 = hist_pick(hist, lane, need, cnt);
                }
                if (cnt <= 64) {
                    asm volatile("s_waitcnt lgkmcnt(0)" ::: "memory");
#pragma unroll 4
                    for (int j = 0; j < 16; ++j) {
                        unsigned wd = 0u;
                        if (j < n4) { const int base = 256 * j + 4 * lane; const f32x4 v = *(const LAS f32x4*)(row + base);
#pragma unroll
                            for (int e = 0; e < 4; ++e) { const float f = fmaf(v[e], fs, fo); const int q1 = min(255, max(0, (int)f));
                                bool sel = q1 > b1, cand = q1 == b1;
                                if (b2 >= 0 && cand) { const int q2 = min(255, max(0, (int)((f - (float)q1) * 256.0f))); sel = q2 > b2; cand = q2 == b2; }
                                if (j >= nfull && base + e >= n) { sel = false; cand = false; }
                                wd |= (sel ? 1u : 0u) << e;
                                if (cand) { const unsigned pos = __hip_atomic_fetch_add(&hist[257], 1u, __ATOMIC_RELAXED, __HIP_MEMORY_SCOPE_WORKGROUP);
                                    if (pos < 64u) { cv[pos] = v[e]; ci[pos] = base + e; } } }
                            wd <<= 4 * (lane & 7);
                            wd |= (unsigned)dppi<0xB1>((int)wd); wd |= (unsigned)dppi<0x4E>((int)wd); wd |= (unsigned)dppi<0x141>((int)wd); }
                        if ((lane & 7) == 0) mrow[8 * j + (lane >> 3)] = wd;
                    }
                    asm volatile("s_waitcnt lgkmcnt(0)" ::: "memory");
                    float myv = 0.f; int myi = 0; int rank = 1 << 30;
                    if (lane < cnt) { myv = cv[lane]; myi = ci[lane]; rank = 0; }
                    for (int k = 0; k < cnt; ++k) { const float vk = cv[k]; const int ik = ci[k]; if (lane < cnt && (vk > myv || (vk == myv && ik < myi))) ++rank; }
                    if (rank < need) __hip_atomic_fetch_or(&mrow[myi >> 5], 1u << (myi & 31), __ATOMIC_RELAXED, __HIP_MEMORY_SCOPE_WORKGROUP);
                    done = true;
                }
            }
            if (!done) {
                float thr_v = 0.f; int thr_i = -1; bool have = false;
                unsigned prefix = 0u; int need = TOPK, cnt = 0;
                for (int pass = 0; pass < 4; ++pass) {
                    const int shift = 24 - 8 * pass;
                    for (int i = lane; i < 256; i += 64) hist[i] = 0u;
                    asm volatile("s_waitcnt lgkmcnt(0)" ::: "memory");
                    for (int i = lane; i < n; i += 64) { const unsigned uk = okey(row[i]);
                        const bool match = (pass == 0) || ((uk >> (shift + 8)) == prefix);
                        if (match) __hip_atomic_fetch_add(&hist[(uk >> shift) & 255u], 1u, __ATOMIC_RELAXED, __HIP_MEMORY_SCOPE_WORKGROUP); }
                    asm volatile("s_waitcnt lgkmcnt(0)" ::: "memory");
                    prefix = (prefix << 8) | (unsigned)hist_pick(hist, lane, need, cnt);
                }
                int rem = need;
                for (int c = 0; c < ((n + 63) >> 6) && !have; ++c) { const int i = 64 * c + lane; const bool eqb = (i < n) && (okey(row[i]) == prefix);
                    unsigned long long eq = __ballot(eqb); const int pe = __popcll(eq);
                    if (pe >= rem) { for (int k = 1; k < rem; ++k) eq &= eq - 1ull; const int src = __ffsll((long long)eq) - 1;
                        thr_i = 64 * c + src; thr_v = row[thr_i]; have = true; } else rem -= pe; }
                for (int j = 0; j < 16; ++j) {
                    unsigned wd = 0u;
                    if (j < n4) { const int base = 256 * j + 4 * lane; const f32x4 v = *(const LAS f32x4*)(row + base);
#pragma unroll
                        for (int e = 0; e < 4; ++e) { const bool bit = (base + e < n) && ((v[e] > thr_v) || (v[e] == thr_v && base + e <= thr_i)); wd |= (bit ? 1u : 0u) << e; }
                        wd <<= 4 * (lane & 7);
                        wd |= (unsigned)dppi<0xB1>((int)wd); wd |= (unsigned)dppi<0x4E>((int)wd); wd |= (unsigned)dppi<0x141>((int)wd); }
                    if ((lane & 7) == 0) mrow[8 * j + (lane >> 3)] = wd;
                }
            }
        }
    }
    lds_barrier();
    {
        const int wq = tid >> 2, sh = 8 * (tid & 3);
        unsigned long long x = 0ull;
#pragma unroll
        for (int tl = 0; tl < 8; ++tl) { const unsigned wv = ((const LAS unsigned*)(sc + tl * 4096))[wq]; x |= (unsigned long long)((wv >> sh) & 0xFFu) << (8 * tl); }
        unsigned long long t_;
        t_ = (x ^ (x >> 7)) & 0x00AA00AA00AA00AAull; x = x ^ t_ ^ (t_ << 7);
        t_ = (x ^ (x >> 14)) & 0x0000CCCC0000CCCCull; x = x ^ t_ ^ (t_ << 14);
        t_ = (x ^ (x >> 28)) & 0x00000000F0F0F0F0ull; x = x ^ t_ ^ (t_ << 28);
        const int qw = t0 >> 5, q8 = (t0 >> 3) & 3;
        const size_t W = ((((size_t)(b * 128 + qw) * 64 + (tid >> 3)) * 2 + ((tid >> 2) & 1)) * 16 + 4 * (tid & 3));
        unsigned char* dst = MTB + W * 8 + q8;
#pragma unroll
        for (int j = 0; j < 8; ++j) dst[(j & 3) * 8 + (j >> 2) * 4] = (unsigned char)(x >> (8 * j));
    }
    lds_barrier();
}

__device__ __forceinline__ int queue_tok0_16(int it) { const int idx = it - NB * NG, pblk = (SL / 16 - 1) - (idx >> 2), bb = idx & 3; return bb * SL + 16 * pblk; }
__device__ __forceinline__ void select_tile16(const Params& p, int tok0, LAS unsigned char* lds) {
    int tid = threadIdx.x; asm volatile("" : "+v"(tid));
    const int lane = tid & 63, wave = __builtin_amdgcn_readfirstlane(tid >> 6);
    constexpr int SCP = 4112;
    constexpr int HWU = 260;
    LAS unsigned short* sc = (LAS unsigned short*)lds;
    LAS unsigned* hst = (LAS unsigned*)(lds + 16 * SCP * 2);
    static_assert(16 * SCP * 2 + 16 * HWU * 4 + 64 <= LDS_BYTES, "LDS");
    const h16* QI = (const h16*)(p.ws + WS_QI); const h16* KIF = (const h16*)(p.ws + WS_KIF); const float* WI = (const float*)(p.ws + WS_WI);
    unsigned char* MTB = (unsigned char*)(p.ws + WS_MASK);
    const int b = tok0 >> 12, t0 = tok0 & (SL - 1), nk = t0 + 16, nsub = (nk > TOPK) ? ((nk + 31) >> 5) : 0;
    for (int i = tid; i < 16 * HWU; i += NT) hst[i] = 0u;
    if (nsub > 0) {
        const int z0 = 32 * nsub, nch = ((((nk + 511) >> 9) << 9) - z0) >> 3;
        LAS unsigned short* zr = sc + (tid >> 5) * SCP + z0;
        for (int c = tid & 31; c < nch; c += 32) *(LAS pg8::u32x4*)(zr + 8 * c) = (pg8::u32x4){0u, 0u, 0u, 0u};
    }
    lds_barrier();
    if (nsub > 0) {
        typedef float f32x4v __attribute__((ext_vector_type(4)));
        const int q4 = lane >> 4, c16 = lane & 15;
        h16x8 qa[8][2], wf[4];
#pragma unroll
        for (int mt = 0; mt < 8; ++mt) { const h16* qp = QI + (size_t)(tok0 + 2 * mt + (c16 >> 3)) * 512 + (c16 & 7) * 64 + 8 * q4;
#pragma unroll
            for (int ks = 0; ks < 2; ++ks) qa[mt][ks] = *(const h16x8*)(qp + 32 * ks); }
        { const f32x4v wv = *(const f32x4v*)(WI + (size_t)(tok0 + c16) * 8 + 4 * (q4 & 1));
#pragma unroll
          for (int u = 0; u < 4; ++u)
#pragma unroll
            for (int j = 0; j < 8; ++j) wf[u][j] = (((c16 >> 2) == u) && ((c16 & 1) == (q4 >> 1)) && ((j >> 2) == ((c16 & 3) >> 1))) ? (h16)wv[j & 3] : (h16)0.f; }
        const int nmine = (nsub > wave) ? ((nsub - wave + NWAVES - 1) / NWAVES) : 0;
        const h16* kbase = KIF + (size_t)(b * (SL / 16)) * 1024 + lane * 8;
        LAS unsigned short* scl = sc + (4 * q4) * SCP + c16;
        LAS unsigned* hl = hst + (4 * q4) * HWU;
        const int clim = t0 + 4 * q4 - c16;
#define QK16(Cv, kf) do { _Pragma("unroll") for (int mt_ = 0; mt_ < 8; ++mt_) Cv[mt_] = (f32x4v){0.f, 0.f, 0.f, 0.f}; \
        _Pragma("unroll") for (int ks_ = 0; ks_ < 2; ++ks_) _Pragma("unroll") for (int mt_ = 0; mt_ < 8; ++mt_) Cv[mt_] = __builtin_amdgcn_mfma_f32_16x16x32_f16(qa[mt_][ks_], kf[ks_], Cv[mt_], 0, 0, 0); } while (0)
#define FIN16(Cv, sub_, nt_) do { f32x4v Y_ = {0.f, 0.f, 0.f, 0.f}; \
        _Pragma("unroll") for (int u_ = 0; u_ < 4; ++u_) { pg8::u32x4 x_; \
            x_.x = relu_pkh(Cv[2 * u_][0], Cv[2 * u_][1]); x_.y = relu_pkh(Cv[2 * u_][2], Cv[2 * u_][3]); x_.z = relu_pkh(Cv[2 * u_ + 1][0], Cv[2 * u_ + 1][1]); x_.w = relu_pkh(Cv[2 * u_ + 1][2], Cv[2 * u_ + 1][3]); \
            Y_ = __builtin_amdgcn_mfma_f32_16x16x32_f16(wf[u_], __builtin_bit_cast(h16x8, x_), Y_, 0, 0, 0); } \
        const int kb_ = 32 * (sub_) + 16 * (nt_); \
        unsigned k01_ = okey2(pkh2(Y_[0], Y_[1])), k23_ = okey2(pkh2(Y_[2], Y_[3])); \
        if (kb_ + 15 > t0) { const int d_ = kb_ - clim;                                     \
            k01_ = ((d_ <= 0) ? (k01_ & 0xFFFFu) : 0u) | ((d_ <= 1) ? (k01_ & 0xFFFF0000u) : 0u); k23_ = ((d_ <= 2) ? (k23_ & 0xFFFFu) : 0u) | ((d_ <= 3) ? (k23_ & 0xFFFF0000u) : 0u); } \
        LAS unsigned short* sp_ = scl + kb_; \
        sp_[0] = (unsigned short)k01_; sp_[SCP] = (unsigned short)(k01_ >> 16); sp_[2 * SCP] = (unsigned short)k23_; sp_[3 * SCP] = (unsigned short)(k23_ >> 16); \
        __hip_atomic_fetch_add(&hl[(k01_ >> 8) & 0xFFu], 1u, __ATOMIC_RELAXED, __HIP_MEMORY_SCOPE_WORKGROUP); \
        __hip_atomic_fetch_add(&hl[HWU + (k01_ >> 24)], 1u, __ATOMIC_RELAXED, __HIP_MEMORY_SCOPE_WORKGROUP); \
        __hip_atomic_fetch_add(&hl[2 * HWU + ((k23_ >> 8) & 0xFFu)], 1u, __ATOMIC_RELAXED, __HIP_MEMORY_SCOPE_WORKGROUP); \
        __hip_atomic_fetch_add(&hl[3 * HWU + (k23_ >> 24)], 1u, __ATOMIC_RELAXED, __HIP_MEMORY_SCOPE_WORKGROUP); } while (0)
#define KLD16(dst, sub_, nt_) do { _Pragma("unroll") for (int ks_ = 0; ks_ < 2; ++ks_) dst[ks_] = *(const h16x8*)(kbase + (size_t)(2 * (sub_) + (nt_)) * 1024 + 512 * ks_); } while (0)
        if (nmine > 0) {
            const int rot = (int)((blockIdx.x * 11u) % (unsigned)nmine);
            h16x8 k0[2], k1[2], k0n[2]; f32x4v C0[8], C1[8];
            int kr = rot;
            KLD16(k0, wave + NWAVES * kr, 0); KLD16(k1, wave + NWAVES * kr, 1);
            QK16(C0, k0);
            for (int k = 0; k < nmine; ++k) {
                const int sub = wave + NWAVES * kr;
                int krn = kr + 1; if (krn == nmine) krn = 0;
                const int subn = wave + NWAVES * krn;
                KLD16(k0n, subn, 0);
                QK16(C1, k1);
                KLD16(k1, subn, 1);
                FIN16(C0, sub, 0);
                QK16(C0, k0n);
                FIN16(C1, sub, 1);
                kr = krn;
            }
        }
#undef QK16
#undef FIN16
#undef KLD16
    }
    lds_barrier();
#pragma unroll 1
    for (int rr = 0; rr < 2; ++rr) {
        const int tl = wave + 8 * rr, t = t0 + tl, n = t + 1;
        const LAS unsigned short* row = sc + tl * SCP;
        LAS unsigned* mrow = (LAS unsigned*)(sc + tl * SCP);
        LAS unsigned* hw = hst + tl * HWU;
        if (n <= TOPK) {
#pragma unroll
            for (int k = 0; k < 2; ++k) { const int wq = lane + 64 * k, lo = 32 * wq;
                unsigned src = 0u; if (t >= lo + 31) src = 0xFFFFFFFFu; else if (t >= lo) src = (1u << (t - lo + 1)) - 1u;
                unsigned o = 0u;
#pragma unroll
                for (int e = 0; e < 8; ++e) o |= ((src >> e) & 0x01010101u) << ((e & 1) * 4 + (e >> 1));
                mrow[wq] = o; }
            continue;
        }
        const int n8 = (n + 511) >> 9;
        int need = TOPK, cnt = 0;
        const unsigned d1 = (unsigned)hist_pick(hw, lane, need, cnt);
        for (int i = lane; i < 256; i += 64) hw[i] = 0u;
        asm volatile("s_waitcnt lgkmcnt(0)" ::: "memory");
        const unsigned d1x = (d1 << 8) * 0x00010001u;
#pragma unroll 2
        for (int j = 0; j < n8; ++j) { const pg8::u32x4 w = *(const LAS pg8::u32x4*)(row + 512 * j + 8 * lane);
            const unsigned ww[4] = {w.x ^ d1x, w.y ^ d1x, w.z ^ d1x, w.w ^ d1x};
#pragma unroll
            for (int i = 0; i < 4; ++i) { const unsigned lo = ww[i] & 0xFFFFu, hi2 = ww[i] >> 16;
                if (lo < 256u) __hip_atomic_fetch_add(&hw[lo], 1u, __ATOMIC_RELAXED, __HIP_MEMORY_SCOPE_WORKGROUP);
                if (hi2 < 256u) __hip_atomic_fetch_add(&hw[hi2], 1u, __ATOMIC_RELAXED, __HIP_MEMORY_SCOPE_WORKGROUP); } }
        asm volatile("s_waitcnt lgkmcnt(0)" ::: "memory");
        const unsigned d2 = (unsigned)hist_pick(hw, lane, need, cnt);
        const unsigned thr2 = ((d1 << 8) | d2) * 0x00010001u;
        const unsigned one2 = 0x00010001u;
        const bool alleq = (need == cnt);
        int eqbase = 0;
        for (int j = 0; j < 8; ++j) {
            unsigned wd = 0u;
            if (j < n8) { const pg8::u32x4 w = *(const LAS pg8::u32x4*)(row + 512 * j + 8 * lane);
                const unsigned ww[4] = {w.x, w.y, w.z, w.w};
                unsigned G = 0u, NE = 0u;
#pragma unroll
                for (int i = 0; i < 4; ++i) { G |= pk_min_u16(pk_subsat_u16(ww[i], thr2), one2) << i; NE |= pk_min_u16(ww[i] ^ thr2, one2) << i; }
                const unsigned gtm = (G & 0xFu) | ((G >> 12) & 0xF0u), eqm = ~((NE & 0xFu) | ((NE >> 12) & 0xF0u)) & 0xFFu;
                unsigned take = eqm;
                if (!alleq) {
                    const int c = __popc(eqm); const int incl = wave_incl_scan(c); int rank = eqbase + incl - c; take = 0u;
#pragma unroll
                    for (int e = 0; e < 8; ++e) { const int ps = (e & 1) * 4 + (e >> 1); if ((eqm >> ps) & 1u) { if (rank < need) take |= 1u << ps; ++rank; } }
                    eqbase += __builtin_amdgcn_readlane(incl, 63);
                }
                wd = (gtm | take) << (8 * (lane & 3));
                wd |= (unsigned)dppi<0xB1>((int)wd); wd |= (unsigned)dppi<0x4E>((int)wd); }
            if ((lane & 3) == 0) mrow[16 * j + (lane >> 2)] = wd;
        }
    }
    lds_barrier();
    {
        const int wq = tid >> 2, sh = 8 * (tid & 3);
        const int qw = t0 >> 5, q8 = (t0 >> 3) & 3;
        const size_t W = ((((size_t)(b * 128 + qw) * 64 + (tid >> 3)) * 2 + ((tid >> 2) & 1)) * 16 + 4 * (tid & 3));
#pragma unroll
        for (int hh = 0; hh < 2; ++hh) {
            unsigned long long x = 0ull;
#pragma unroll
            for (int tl = 0; tl < 8; ++tl) { const unsigned wv = ((const LAS unsigned*)(sc + (8 * hh + tl) * SCP))[wq]; x |= (unsigned long long)((wv >> sh) & 0xFFu) << (8 * tl); }
            unsigned long long t_;
            t_ = (x ^ (x >> 7)) & 0x00AA00AA00AA00AAull; x = x ^ t_ ^ (t_ << 7);
            t_ = (x ^ (x >> 14)) & 0x0000CCCC0000CCCCull; x = x ^ t_ ^ (t_ << 14);
            t_ = (x ^ (x >> 28)) & 0x00000000F0F0F0F0ull; x = x ^ t_ ^ (t_ << 28);
            unsigned char* dst = MTB + W * 8 + q8 + hh;
#pragma unroll
            for (int ps = 0; ps < 8; ++ps) { const int j = (ps < 4) ? (2 * ps) : (2 * (ps - 4) + 1);
                dst[(j & 3) * 8 + (j >> 2) * 4] = (unsigned char)(x >> (8 * ps)); }
        }
    }
    lds_barrier();
}

#define SBAR() __builtin_amdgcn_sched_barrier(0)
namespace attn_body {
using bf16=_Float16;
using bf16x8=__attribute__((ext_vector_type(8)))short;
using s16x4=__attribute__((ext_vector_type(4)))short;
using f32x16=__attribute__((ext_vector_type(16)))float;
using u32x4=__attribute__((ext_vector_type(4)))unsigned;
constexpr int BATCH=4,NHEAD=8,SEQ=4096,D=64,DM=NHEAD*D;
constexpr int NW=8,QBLK=32,QB=QBLK*NW,KVBLK=64,NQB=SEQ/QB;
constexpr int ATTN_PITCH=DM, ATTN_UNIT_ROWS=QB, ODM=1024;
typedef _Float16 hx8 __attribute__((ext_vector_type(8)));
__device__ __forceinline__ f32x16 mfma16(bf16x8 a,bf16x8 b,f32x16 c){return __builtin_amdgcn_mfma_f32_32x32x16_f16(__builtin_bit_cast(hx8,a),__builtin_bit_cast(hx8,b),c,0,0,0);}
typedef const __attribute__((address_space(4))) unsigned long long* cmask_ptr;
__device__ __forceinline__ void tmask(f32x16&p0,f32x16&p1,cmask_ptr m,float mh){
  #pragma unroll
  for(int r=0;r<16;++r){p0[r]=__builtin_amdgcn_inverse_ballot_w64(m[r])?p0[r]:-INFINITY; p1[r]=__builtin_amdgcn_inverse_ballot_w64(m[16+r])?p1[r]:-INFINITY;}
}
__device__ __forceinline__ int crow(int r,int hi){return (r&3)+8*(r>>2)+4*hi;}
#define SBAR() __builtin_amdgcn_sched_barrier(0)
__device__ __forceinline__ void cmask(f32x16&p0,f32x16&p1,int jb,int qrel,int hi){
  const float NEG=-INFINITY; int kb=64*jb+4*hi;
  #pragma unroll
  for(int r=0;r<16;++r){int kv=kb+(r&3)+8*(r>>2); if(kv>qrel)p0[r]=NEG; if(kv+32>qrel)p1[r]=NEG;}
}

constexpr int NSLOT=3, SLOTB=8192;
constexpr int LDS_K=0, LDS_V=NSLOT*SLOTB, LDS_WS=2*NSLOT*SLOTB, LDS_OST=LDS_WS+NW*64*4, LDS_BYTES=LDS_OST+NW*4096;
constexpr float C2=0.125f*1.4426950408889634f;
__device__ __forceinline__ void glds16(const void*gsrc,unsigned lds_dst){unsigned keep;
  asm volatile("s_mov_b32 %0, m0\n\ts_mov_b32 m0, %2\n\ts_nop 0\n\tglobal_load_lds_dwordx4 %1, off\n\ts_mov_b32 m0, %0":"=&s"(keep):"v"(gsrc),"s"(lds_dst):"memory");}
__device__ __forceinline__ float max3f(float a,float b,float c){float r;asm("v_max3_f32 %0, %1, %2, %3":"=v"(r):"v"(a),"v"(b),"v"(c));return r;}
__device__ __forceinline__ float max2f(float a,float b){float r;asm("v_max_f32_e32 %0, %1, %2":"=v"(r):"v"(a),"v"(b));return r;}
__device__ __forceinline__ float fadd_s(float a,float b){float r;asm("v_add_f32_e32 %0, %1, %2":"=v"(r):"v"(a),"v"(b));return r;}
__device__ __forceinline__ float fsub_s(float a,float b){float r;asm("v_sub_f32_e32 %0, %1, %2":"=v"(r):"v"(a),"v"(b));return r;}
typedef float f32x2_t __attribute__((ext_vector_type(2))); typedef _Float16 bf16x2_t __attribute__((ext_vector_type(2)));
__device__ __forceinline__ unsigned cvtpk_s(float lo,float hi){f32x2_t v={lo,hi};bf16x2_t b=__builtin_convertvector(v,bf16x2_t);return __builtin_bit_cast(unsigned,b);}
#define WAIT_BAR(N) asm volatile("s_waitcnt vmcnt(" #N ") lgkmcnt(0)\n\ts_barrier":::"memory")

__device__ __forceinline__ void qkt(f32x16&p0,f32x16&p1,const char*Kslot,const bf16x8*qr,const f32x16&negm,int r32,int hi){
  const char*kb=Kslot+hi*1024+r32*16;
  #pragma unroll
  for(int d0=0;d0<4;++d0){
    const bf16x8 b0=*reinterpret_cast<const bf16x8*>(kb+d0*2048);
    const bf16x8 b1=*reinterpret_cast<const bf16x8*>(kb+d0*2048+512);
    if(d0==0){p0=mfma16(b0,qr[0],negm);p1=mfma16(b1,qr[0],negm);}
    else{p0=mfma16(b0,qr[d0],p0);p1=mfma16(b1,qr[d0],p1);}}
}
typedef __attribute__((address_space(3))) const char* lds_cptr;
typedef short v4i16_t __attribute__((ext_vector_type(4)));
__device__ __forceinline__ void kload8(bf16x8*kf,lds_cptr kp){
  kf[0]=*(const __attribute__((address_space(3))) bf16x8*)(kp);      kf[1]=*(const __attribute__((address_space(3))) bf16x8*)(kp+512);
  kf[2]=*(const __attribute__((address_space(3))) bf16x8*)(kp+2048); kf[3]=*(const __attribute__((address_space(3))) bf16x8*)(kp+2560);
  kf[4]=*(const __attribute__((address_space(3))) bf16x8*)(kp+4096); kf[5]=*(const __attribute__((address_space(3))) bf16x8*)(kp+4608);
  kf[6]=*(const __attribute__((address_space(3))) bf16x8*)(kp+6144); kf[7]=*(const __attribute__((address_space(3))) bf16x8*)(kp+6656);
}
__device__ __forceinline__ void kload2(bf16x8*kf,lds_cptr kp,int j){ kf[2*j]=*(const __attribute__((address_space(3))) bf16x8*)(kp+j*2048); kf[2*j+1]=*(const __attribute__((address_space(3))) bf16x8*)(kp+j*2048+512); }
__device__ __forceinline__ s16x4 vtr(lds_cptr p){ return __builtin_bit_cast(s16x4,__builtin_amdgcn_ds_read_tr16_b64_v4i16((__attribute__((address_space(3))) v4i16_t*)p)); }
__device__ __forceinline__ float rowmax(const f32x16&p0,const f32x16&p1){
  float a=max3f(p0[0],p0[1],p1[0]),b=max3f(p0[2],p0[3],p1[1]);a=max3f(a,p1[2],p1[3]);
  #pragma unroll
  for(int r=4;r<16;r+=4){a=max3f(a,p0[r],p0[r+1]);b=max3f(b,p0[r+2],p0[r+3]);a=max3f(a,p1[r],p1[r+1]);b=max3f(b,p1[r+2],p1[r+3]);}
  const float m=max2f(a,b);
  auto rr=__builtin_amdgcn_permlane32_swap(__float_as_uint(m),__float_as_uint(m),false,false);
  return max2f(__uint_as_float(rr[0]),__uint_as_float(rr[1]));
}
__device__ __forceinline__ void pv(f32x16*o,int vb,bf16x8 pa0,bf16x8 pa1,bf16x8 pa2,bf16x8 pa3){
  #pragma unroll
  for(int d0=0;d0<2;++d0){s16x4 lo[4],hi[4];
    #pragma unroll
    for(int ks=0;ks<4;++ks){
      asm volatile("ds_read_b64_tr_b16 %0,%1 offset:%c2":"=&v"(lo[ks]):"v"(vb),"i"(d0*4096+ks*1024):"memory");
      asm volatile("ds_read_b64_tr_b16 %0,%1 offset:%c2":"=&v"(hi[ks]):"v"(vb),"i"(d0*4096+ks*1024+512):"memory");}
    asm volatile("s_waitcnt lgkmcnt(0)":::"memory");SBAR();
    #define PK(k) (bf16x8){lo[k][0],lo[k][1],lo[k][2],lo[k][3],hi[k][0],hi[k][1],hi[k][2],hi[k][3]}
    o[d0]=mfma16(pa0,PK(0),o[d0]);
    o[d0]=mfma16(pa1,PK(1),o[d0]);
    o[d0]=mfma16(pa2,PK(2),o[d0]);
    o[d0]=mfma16(pa3,PK(3),o[d0]);
    #undef PK
  }
}

#ifndef ATTN_STORE16
#define ATTN_STORE16(p,v) (*(u32x4*)(p)=(v))
#endif
template<int THRL> __device__ __forceinline__ void attn_unit(int b,int h,int qb,const bf16*Q,const bf16*__restrict__ K,const bf16*__restrict__ V,bf16*O,const unsigned long long*MT,float*SSQ,char*shm){
  int tid=threadIdx.x; asm volatile("":"+v"(tid)); const int lane=tid&63,r32=lane&31,hi=lane>>5; const int wid=__builtin_amdgcn_readfirstlane(tid>>6);
  const long rowbase=(long)b*SEQ; const int q0=qb*QB;
  const cmask_ptr mt=(cmask_ptr)(MT+((size_t)(b*(SEQ/32)+qb*NW+wid)*(SEQ/64))*32);
  const bf16*Qw=Q+(rowbase+q0+wid*QBLK)*DM+h*D;
  const bf16*Kh=K+rowbase*DM+h*D,*Vh=V+rowbase*DM+h*D;
  const unsigned lds0=(unsigned)(uintptr_t)shm;
  float*wsf=(float*)(shm+LDS_WS)+wid*64;
  const bf16*ksrc=Kh+(long)lane*DM+wid*8;
  const bf16*vsrc=Vh+(long)(16*(wid&3)+(lane>>2))*DM+(wid>>2)*32+(lane&3)*8;
  const unsigned kdst=lds0+LDS_K+wid*1024, vdst=lds0+LDS_V+wid*1024;
  #define DMA_K(t,slot) glds16(ksrc+(long)(t)*KVBLK*DM,(unsigned)__builtin_amdgcn_readfirstlane(kdst+(slot)))
  #define DMA_V(t,slot) glds16(vsrc+(long)(t)*KVBLK*DM,(unsigned)__builtin_amdgcn_readfirstlane(vdst+(slot)))
  const int vb0=(int)(lds0+LDS_V)+((lane>>4)&1)*32+(lane&3)*8+(4*hi+((lane&15)>>2))*64;
  const char*Kbase=shm+LDS_K; bf16x8 kf[8];
  const lds_cptr shm3=(lds_cptr)shm; const lds_cptr kp0=shm3+LDS_K+hi*1024+r32*16; const lds_cptr vp0=shm3+LDS_V+((lane>>4)&1)*32+(lane&3)*8+(4*hi+((lane&15)>>2))*64;
  const int NT=(q0+QB)/KVBLK;
  DMA_K(0,0);DMA_V(0,0);DMA_K(1,SLOTB);
  bf16x8 qr[4];
  #pragma unroll
  for(int d0=0;d0<4;++d0)qr[d0]=*reinterpret_cast<const bf16x8*>(&Qw[(long)r32*DM+d0*16+hi*8]);
  float mhat=0.f,l_reg=0.f;f32x16 o[2];o[0]=f32x16{};o[1]=f32x16{};f32x16 negm=f32x16{};asm volatile("":"+v"(negm));
  const int qrel=wid*QBLK+r32;
  #define CMASK(P0,P1,t) tmask(P0,P1,mt+(t)*32,mhat)
  bool resc=false;
  #define START(P0,P1) do{ const float rm=rowmax(P0,P1); resc=false; \
    { const float dl=__builtin_fmaxf(rm,-64.f); mhat=fadd_s(mhat,dl); \
      _Pragma("unroll") for(int r=0;r<16;++r){P0[r]=fsub_s(P0[r],dl);P1[r]=fsub_s(P1[r],dl);} \
      _Pragma("unroll") for(int r=0;r<16;++r)negm[r]=-mhat; asm volatile("":"+v"(negm)); } \
    _Pragma("unroll") for(int r=0;r<16;++r)P0[r]=__builtin_amdgcn_exp2f(P0[r]); }while(0)
  #define RESC() do{ if(resc){ asm volatile("s_waitcnt lgkmcnt(0)":::"memory"); \
      _Pragma("unroll") for(int d_=0;d_<2;++d_) _Pragma("unroll") for(int r=0;r<16;++r)o[d_][r]*=wsf[crow(r,hi)]; } }while(0)
  f32x16 pA0,pA1,pB0,pB1;
  int sl_prev=0,sl_cur=0,sl_next=SLOTB;
  #define ROT() do{sl_prev=sl_cur;sl_cur=sl_next;sl_next=(sl_next==(NSLOT-1)*SLOTB)?0:sl_next+SLOTB;}while(0)
  DMA_K(2,2*SLOTB);
  WAIT_BAR(3);
  qkt(pA0,pA1,Kbase,qr,negm,r32,hi);asm volatile("s_nop 15\n\ts_nop 7":"+v"(pA0),"+v"(pA1));CMASK(pA0,pA1,0);
  START(pA0,pA1);
  _Pragma("unroll") for(int r=0;r<16;++r)pA1[r]=__builtin_amdgcn_exp2f(pA1[r]);
  WAIT_BAR(0);
  DMA_K(3,0);DMA_V(1,SLOTB);
  ROT();
  kload8(kf,kp0+sl_cur);
  WAIT_BAR(2);
  s16x4 vlo[8],vhi[8]; u32x4 pw0,pw1,pw2,pw3;
  #define PKW(P,B) cvtpk_s(P[B],P[B+1])
  #define PAF(k) __builtin_bit_cast(bf16x8,pw##k)
  #define VFR(i) (bf16x8){vlo[i][0],vlo[i][1],vlo[i][2],vlo[i][3],vhi[i][0],vhi[i][1],vhi[i][2],vhi[i][3]}
  #define PIN(x) asm volatile("":"+v"(x))
  #define MX3(a,b,c) __builtin_fmaxf(__builtin_fmaxf((a),(b)),(c))
  #define GAPA(MF,A0,A1,A2,A3,W0,W1,PW) do{ MF; sacc+=A0; sacc+=A1; sacc+=A2; sacc+=A3; PIN(sacc); W0; W1; PIN(PW); SBAR(); }while(0)
  #define EX(v) __builtin_amdgcn_exp2f(v)
  #define GAPB(MF,X,B) do{ MF; X[B]=EX(X[B]); X[B+1]=EX(X[B+1]); X[B+2]=EX(X[B+2]); X[B+3]=EX(X[B+3]); PIN(X); SBAR(); }while(0)
  #define VRD(i) do{ vlo[i]=vtr(vp_+(((i)>>2)*4096+((i)&3)*1024)); vhi[i]=vtr(vp_+(((i)>>2)*4096+((i)&3)*1024+512)); }while(0)
  #define KRD(G,j) do{ if(G){ kload2(kf,kp0+sl_next,j); SBAR(); } }while(0)
  #define STEP(C0,C1,P0,P1,t,GK,GV,GL) do{ SBAR(); \
    const lds_cptr vp_=vp0+sl_prev; \
    VRD(0); SBAR(); float sacc=(P0[0]+P0[1]); \
    GAPA(C0=mfma16(kf[0],qr[0],negm), P0[2],P0[3],P0[4],P0[5],     pw0[0]=PKW(P0,0), pw0[1]=PKW(P0,2), pw0); \
    VRD(4); SBAR(); GAPA(C1=mfma16(kf[1],qr[0],negm), P0[6],P0[7],P0[8],P0[9],     pw0[2]=PKW(P0,4), pw0[3]=PKW(P0,6), pw0); \
    VRD(1); SBAR(); GAPA(C0=mfma16(kf[2],qr[1],C0),   P0[10],P0[11],P0[12],P0[13], pw1[0]=PKW(P0,8), pw1[1]=PKW(P0,10), pw1); \
    VRD(5); SBAR(); GAPA(C1=mfma16(kf[3],qr[1],C1),   P0[14],P0[15],P1[0],P1[1],   pw1[2]=PKW(P0,12),pw1[3]=PKW(P0,14), pw1); \
    VRD(2); SBAR(); GAPA(C0=mfma16(kf[4],qr[2],C0),   P1[2],P1[3],P1[4],P1[5],     pw2[0]=PKW(P1,0), pw2[1]=PKW(P1,2), pw2); \
    VRD(6); SBAR(); GAPA(C1=mfma16(kf[5],qr[2],C1),   P1[6],P1[7],P1[8],P1[9],     pw2[2]=PKW(P1,4), pw2[3]=PKW(P1,6), pw2); \
    VRD(3); SBAR(); GAPA(C0=mfma16(kf[6],qr[3],C0),   P1[10],P1[11],P1[12],P1[13], pw3[0]=PKW(P1,8), pw3[1]=PKW(P1,10), pw3); \
    VRD(7); SBAR(); GAPA(C1=mfma16(kf[7],qr[3],C1),   P1[14],P1[15],0.f,0.f,       pw3[2]=PKW(P1,12),pw3[3]=PKW(P1,14), pw3); \
    l_reg+=sacc; \
    if(GK){DMA_K((t)+3,sl_cur);} if(GV){DMA_V((t)+1,sl_next);} \
    CMASK(C0,C1,t); \
    { float a=MX3(C0[0],C0[1],C1[0]),b=MX3(C0[2],C0[3],C1[1]); a=MX3(a,C1[2],C1[3]); \
      _Pragma("unroll") for(int r=4;r<16;r+=4){a=MX3(a,C0[r],C0[r+1]);b=MX3(b,C0[r+2],C0[r+3]);a=MX3(a,C1[r],C1[r+1]);b=MX3(b,C1[r+2],C1[r+3]);} \
      float rm=__builtin_fmaxf(a,b); { auto rr=__builtin_amdgcn_permlane32_swap(__float_as_uint(rm),__float_as_uint(rm),false,false); rm=__builtin_fmaxf(__uint_as_float(rr[0]),__uint_as_float(rr[1])); } \
      resc=false; \
      if(__builtin_expect(__any(rm>(float)THRL),0)){ const float dl=__builtin_fmaxf(rm,0.f); mhat+=dl; \
        _Pragma("unroll") for(int r=0;r<16;++r){C0[r]-=dl;C1[r]-=dl;} \
        _Pragma("unroll") for(int r=0;r<16;++r)negm[r]=-mhat; asm volatile("":"+v"(negm)); \
        const float f=__builtin_amdgcn_exp2f(-dl); l_reg*=f; if(hi==0)wsf[r32]=f; resc=true; } } \
    SBAR(); \
    GAPB(o[0]=mfma16(PAF(0),VFR(0),o[0]), C0,0); \
    GAPB(o[1]=mfma16(PAF(0),VFR(4),o[1]), C0,4); \
    KRD(GL,0); GAPB(o[0]=mfma16(PAF(1),VFR(1),o[0]), C0,8); \
    KRD(GL,1); GAPB(o[1]=mfma16(PAF(1),VFR(5),o[1]), C0,12); \
    KRD(GL,2); GAPB(o[0]=mfma16(PAF(2),VFR(2),o[0]), C1,0); \
    KRD(GL,3); GAPB(o[1]=mfma16(PAF(2),VFR(6),o[1]), C1,4); \
    GAPB(o[0]=mfma16(PAF(3),VFR(3),o[0]), C1,8); \
    GAPB(o[1]=mfma16(PAF(3),VFR(7),o[1]), C1,12); \
    }while(0)
  int t=1;
  for(;t+5<NT;t+=2){
    STEP(pB0,pB1,pA0,pA1,t,true,true,true);     WAIT_BAR(2); RESC(); ROT();
    STEP(pA0,pA1,pB0,pB1,t+1,true,true,true);   WAIT_BAR(2); RESC(); ROT();
  }
  #define ENDW(tt) do{ if((tt)+3<NT){WAIT_BAR(2);} else if((tt)+2<NT){WAIT_BAR(1);} else {WAIT_BAR(0);} }while(0)
  for(;t+1<NT;t+=2){
    STEP(pB0,pB1,pA0,pA1,t,(t+3<NT),(t+1<NT),(t+1<NT));       ENDW(t);   RESC(); ROT();
    STEP(pA0,pA1,pB0,pB1,t+1,(t+4<NT),(t+2<NT),(t+2<NT));     ENDW(t+1); RESC(); ROT();
  }
  STEP(pB0,pB1,pA0,pA1,NT-1,false,false,false); RESC();
  { float sacc=pB0[0]+pB0[1]; _Pragma("unroll") for(int r=2;r<16;++r)sacc+=pB0[r]; _Pragma("unroll") for(int r=0;r<16;++r)sacc+=pB1[r]; l_reg+=sacc;
    pw0=(u32x4){PKW(pB0,0),PKW(pB0,2),PKW(pB0,4),PKW(pB0,6)};pw1=(u32x4){PKW(pB0,8),PKW(pB0,10),PKW(pB0,12),PKW(pB0,14)};pw2=(u32x4){PKW(pB1,0),PKW(pB1,2),PKW(pB1,4),PKW(pB1,6)};pw3=(u32x4){PKW(pB1,8),PKW(pB1,10),PKW(pB1,12),PKW(pB1,14)};
    SBAR(); pv(o,vb0+sl_cur,PAF(0),PAF(1),PAF(2),PAF(3)); }
  #undef PKW
  #undef PAF
  #undef VFR
  #undef PIN
  #undef MX3
  #undef GAPA
  #undef GAPB
  #undef EX
  #undef VRD
  #undef KRD
  #undef STEP
  #undef ENDW
  {auto rr=__builtin_amdgcn_permlane32_swap(__float_as_uint(l_reg),__float_as_uint(l_reg),false,false);l_reg=__uint_as_float(rr[0])+__uint_as_float(rr[1]);}
  if(hi==0)wsf[32+r32]=l_reg;asm volatile("s_waitcnt lgkmcnt(0)":::"memory");
  float rli[16];
  #pragma unroll
  for(int r=0;r<16;++r)rli[r]=__builtin_amdgcn_rcpf(wsf[32+crow(r,hi)]);
  bf16*Ow=O+(rowbase+q0+wid*QBLK)*ODM+h*D;
  { bf16*stg=(bf16*)(shm+LDS_OST)+wid*2048;
    #pragma unroll
    for(int r=0;r<16;++r){const int orow=crow(r,hi);
      #pragma unroll
      for(int d0=0;d0<2;++d0)stg[orow*64+d0*32+r32]=(bf16)(o[d0][r]*rli[r]);}
    asm volatile("s_waitcnt lgkmcnt(0)":::"memory");
    #pragma unroll
    for(int i=0;i<4;++i){const int row=i*8+(lane>>3),ch=lane&7; const u32x4 v=*(const u32x4*)(stg+row*64+ch*8); ATTN_STORE16(Ow+(long)row*ODM+ch*8,v);
      const hx8 hv=__builtin_bit_cast(hx8,v); float sq=0.f;
      #pragma unroll
      for(int e=0;e<8;++e){const float f=(float)hv[e]; sq+=f*f;}
      sq+=__shfl_xor(sq,1); sq+=__shfl_xor(sq,2); sq+=__shfl_xor(sq,4);
      if(ch==0)atomicAdd(SSQ+rowbase+q0+wid*QBLK+row,sq);} }
  asm volatile("s_waitcnt lgkmcnt(0)\n\ts_barrier":::"memory");
  #undef DMA_K
  #undef DMA_V
  #undef CMASK
  #undef START
  #undef RESC
  #undef ROT
}
constexpr int ATTN_LDS_BYTES=LDS_BYTES;
struct AttnTensors { const bf16* Q; const bf16* K; const bf16* V; bf16* O; const unsigned long long* MT; float* SSQ; };
struct AttnUnit { int bh; int qb; };
struct StaticOrder {
  int vcu;
  __device__ __forceinline__ explicit StaticOrder(int grid,int block):vcu((block%8)*(grid/8)+block/8){}
  __device__ __forceinline__ bool next(int i,AttnUnit&u)const{ if(i>=2)return false; const int s=vcu&7; u.bh=vcu>>3; u.qb=(i==0)?15-s:s; return true; }
  __device__ __forceinline__ void a_ready(const AttnUnit&)const{}
  __device__ __forceinline__ void done(const AttnUnit&)const{}
};
template<class Sched,int THRL=8> __device__ __forceinline__ void attn_phase(char*lds,const AttnTensors&T,const Sched&S){
  AttnUnit u;
  for(int i=0;S.next(i,u);++i){ S.a_ready(u); attn_unit<THRL>(u.bh/NHEAD,u.bh%NHEAD,u.qb,T.Q,T.K,T.V,T.O,T.MT,T.SSQ,lds); S.done(u); }
}
#undef SBAR
#undef WAIT_BAR
}

__device__ __forceinline__ void p6_mix_rows(const Params& p, int gw, int NGW, int lane) {
    const h16* YG = (const h16*)(p.ws + WS_YG); const h16* YA = (const h16*)(p.ws + WS_YA); h16* YMIX = (h16*)(p.ws + WS_YMIX);
    for (int m = gw; m < M; m += NGW) {
#pragma unroll
        for (int half = 0; half < 2; ++half) {
            const h16* src = (half ? YA : YG) + (size_t)m * 512 + 8 * lane; const float* gwt = (half ? p.on_attn : p.on_ssm) + 8 * lane;
            const h16x8 v = *(const h16x8*)src; float f[8]; float s = 0.f;
#pragma unroll
            for (int e = 0; e < 8; ++e) { f[e] = (float)v[e]; s += f[e] * f[e]; }
            const float rstd = 1.0f / sqrtf(wave_sum(s) * (1.0f / 512.0f) + EPS);
            const f32x4 g0 = *(const f32x4*)gwt, g1 = *(const f32x4*)(gwt + 4);
            u32x4 w; w.x = pkh(f[0] * rstd * g0[0], f[1] * rstd * g0[1]); w.y = pkh(f[2] * rstd * g0[2], f[3] * rstd * g0[3]);
            w.z = pkh(f[4] * rstd * g1[0], f[5] * rstd * g1[1]); w.w = pkh(f[6] * rstd * g1[2], f[7] * rstd * g1[3]);
            *(u32x4*)(YMIX + (size_t)m * DM + half * 512 + 8 * lane) = w;
        }
    }
}

#define XB_TMO      128
#define XB_XCNT(j)  (256  + 64 * (j))
#define XB_XSUB(j)  (1280 + 64 * (j))
#define XB_XGEN(j)  (2304 + 64 * (j))
#define XB_TOP      3328
#define XB_TOPGEN   3392
#define XCD_BAR_WORDS 3456
#define XB_SPIN_CAP (1u << 18)

__device__ __forceinline__ unsigned xb_ld(unsigned* p)              { return __hip_atomic_load(p, __ATOMIC_RELAXED, __HIP_MEMORY_SCOPE_AGENT); }
__device__ __forceinline__ unsigned xb_add(unsigned* p, unsigned v) { return __hip_atomic_fetch_add(p, v, __ATOMIC_RELAXED, __HIP_MEMORY_SCOPE_AGENT); }
__device__ __forceinline__ unsigned xb_xcc_id() { return (unsigned)__builtin_amdgcn_s_getreg((3 << 11) | 20) & 0xFu; }
#define XB_SPIN(cond, bar) do { unsigned _sp = 0; while (cond) { __builtin_amdgcn_s_sleep(1); \
    if ((++_sp & 255u) == 0u) { if (xb_ld(&(bar)[XB_TMO])) break; if (_sp > XB_SPIN_CAP) { atomicAdd(&(bar)[XB_TMO], 1u); break; } } } } while (0)

struct XcdBarrier {
    unsigned* bar; unsigned x;
    volatile LAS unsigned* st;
};

__device__ __forceinline__ XcdBarrier xcd_barrier_post(unsigned* bar, volatile LAS unsigned* st) {
    XcdBarrier b; b.bar = bar; b.x = xb_xcc_id(); b.st = st;
    if (threadIdx.x == 0) (void)xb_add(&bar[XB_XCNT(b.x)], 1u);
    return b;
}
__device__ __forceinline__ void xcd_barrier_complete(unsigned* bar, unsigned x, unsigned& nloc, unsigned& nx) {
    const unsigned G = gridDim.x * gridDim.y * gridDim.z;
    unsigned sum, cnt, mine, sp = 0u;
    for (;;) {
        sum = 0u; cnt = 0u; mine = 0u;
#pragma unroll
        for (unsigned j = 0; j < 16; ++j) { const unsigned c = xb_ld(&bar[XB_XCNT(j)]); sum += c; cnt += (c > 0u) ? 1u : 0u; mine = (j == x) ? c : mine; }
        if (sum == G) break;
        __builtin_amdgcn_s_sleep(1);
        if ((++sp & 255u) == 0u) { if (xb_ld(&bar[XB_TMO])) break; if (sp > XB_SPIN_CAP) { atomicAdd(&bar[XB_TMO], 1u); break; } }
    }
    nloc = mine > 0u ? mine : 1u; nx = cnt > 0u ? cnt : 1u;
}

__device__ __forceinline__ void xcd_barrier(const XcdBarrier& b) {
    asm volatile("s_waitcnt vmcnt(0)" ::: "memory");
    __syncthreads();
    if (threadIdx.x == 0) {
        unsigned* bar = b.bar;
        __builtin_amdgcn_s_waitcnt(0);
        unsigned nloc = b.st[0], nx = b.st[1];
        if (nloc == 0u) { xcd_barrier_complete(bar, b.x, nloc, nx); b.st[0] = nloc; b.st[1] = nx; }
        const unsigned old = xb_add(&bar[XB_XSUB(b.x)], 1u);
        const unsigned gen = old / nloc;
        if (old + 1u == (gen + 1u) * nloc) {
            __builtin_amdgcn_fence(__ATOMIC_RELEASE, "agent");
            asm volatile("s_waitcnt vmcnt(0)" ::: "memory");
            const unsigned og = xb_add(&bar[XB_TOP], 1u);
            const unsigned tg = og / nx;
            if (og + 1u == (tg + 1u) * nx) xb_add(&bar[XB_TOPGEN], 1u);
            else XB_SPIN(xb_ld(&bar[XB_TOPGEN]) == tg, bar);
            __builtin_amdgcn_fence(__ATOMIC_ACQUIRE, "agent");
            xb_add(&bar[XB_XGEN(b.x)], 1u);
            asm volatile("s_waitcnt vmcnt(0)" ::: "memory");
        } else {
            XB_SPIN(xb_ld(&bar[XB_XGEN(b.x)]) == gen, bar);
            __builtin_amdgcn_fence(__ATOMIC_ACQUIRE, "agent");
            asm volatile("s_waitcnt vmcnt(0)" ::: "memory");
        }
    }
    __syncthreads();
}

__global__ void __launch_bounds__(NT, 2) fwd_mega(Params p) {
    extern __shared__ __attribute__((aligned(16))) unsigned char lds_raw[];
    LAS unsigned char* lds = (LAS unsigned char*)lds_raw;
    cg::grid_group grid = cg::this_grid();
    const int tid = threadIdx.x, lane = tid & 63, wave = __builtin_amdgcn_readfirstlane(tid >> 6);
    const int G = gridDim.x, gw = blockIdx.x * NWAVES + wave, NGW = G * NWAVES;
    unsigned char* ws = p.ws;
    unsigned* ctl = (unsigned*)(ws + WS_CTL);
    const float* MOD = (const float*)(ws + WS_CTL + CTL_MOD_OFF);
    h16* HN = (h16*)(ws + WS_HN);
    volatile LAS unsigned* bst = (volatile LAS unsigned*)(lds + LDS_BYTES - 32);
    if (tid < 2) bst[tid] = 0u;
    __syncthreads();
    const XcdBarrier bar = xcd_barrier_post(ctl + CW_BAR, bst);
#define GRID_BAR() xcd_barrier(bar)

    p0_prologue(p, lds, gw, NGW, wave, lane);
    for (int it = (int)blockIdx.x; it < NG * 8; it += G) s5_tables(p, it, lds);
    if (p.use_cg_sync) grid.sync();
    GRID_BAR();
    norm_mod_rows(p.x, p.norm_mix, MOD, 0, DM, HN, gw, NGW, lane);
    GRID_BAR();
    bias2_rows(p, MOD, gw, NGW, lane);
    { pg8::Gemm g{HN, (const h16*)(ws + WS_WIN), M, NPROJ_PAD, DM, DM}; pg8::StaticOrder S; S.init(M, NPROJ_PAD, G, (int)blockIdx.x);
      const float* RCp = (const float*)(ws + WS_ROPE);
      EpiProj E{(h16*)(ws + WS_U), (h16*)(ws + WS_Q), (h16*)(ws + WS_K), (h16*)(ws + WS_V), (h16*)(ws + WS_QI), (h16*)(ws + WS_KIF), (float*)(ws + WS_WI), RCp, RCp + (size_t)M * 32, p.q_norm, p.k_norm};
      pg8::gemm_phase<EpiProj, pg8::StaticOrder, true, true>(lds, g, S, E); }
    GRID_BAR();
    {
        LAS int* slot = (LAS int*)(lds + LDS_BYTES - 64);
        int nxt = 0; TilePrefetch pf; pf.tok0 = -1;
        nxt = (int)blockIdx.x;
        for (int round = 0;; ++round) {
            lds_barrier();
            if (tid == 0) *slot = nxt;
            lds_barrier();
            const int it = *slot;
            if (it >= NB * NG + M / 16) break;
            if (round == 0) nxt = (int)(blockIdx.x + gridDim.x);
            else if (tid == 0) nxt = (int)atomicAdd(ctl + CW_Q4, 1u) + 2 * (int)gridDim.x;
            if (it < NB * NG) s5_unit_mfma(p, it, lds);
            else select_tile16(p, queue_tok0_16(it), lds);
        }
    }
    GRID_BAR();
    {
        const attn_body::AttnTensors AT{(const h16*)(ws + WS_Q), (const h16*)(ws + WS_K), (const h16*)(ws + WS_V), (h16*)(ws + WS_YMIX) + 512, (const unsigned long long*)(ws + WS_MASK), (float*)(ws + WS_CTL + CTL_SSQA_OFF)};
        const attn_body::StaticOrder SA((int)G, (int)blockIdx.x);
        attn_body::attn_phase<attn_body::StaticOrder>((char*)lds_raw, AT, SA);
        pg8::Gemm g{(const h16*)(ws + WS_YS), (const h16*)(ws + WS_WGLU), M, DSSM, DSSM, DSSM}; pg8::StaticOrder S; S.init(M, DSSM, G, (int)blockIdx.x);
        EpiGlu E{(const h16*)(ws + WS_YS), (h16*)(ws + WS_YMIX), p.b_glu, (float*)(ws + WS_CTL + CTL_SSQS_OFF)};
        pg8::gemm_phase<EpiGlu, pg8::StaticOrder, true, true>(lds, g, S, E);
    }
    GRID_BAR();
    { pg8::Gemm g{(const h16*)(ws + WS_YMIX), (const h16*)(ws + WS_WOUT), M, DM, DM, DM}; pg8::StaticOrder S; S.init(M, DM, G, (int)blockIdx.x);
      EpiResidNorm E{p.x, p.out, MOD + 2 * DM, p.norm_ffn, MOD + 4 * DM, HN, (float*)(ws + WS_CTL + CTL_SSQ2_OFF), (const float*)(ws + WS_CTL + CTL_SSQS_OFF), (const float*)(ws + WS_CTL + CTL_SSQA_OFF)};
      pg8::gemm_phase<EpiResidNorm, pg8::StaticOrder, true, true>(lds, g, S, E); }
    GRID_BAR();
    { pg8::Gemm g{HN, (const h16*)(ws + WS_WUP), M, DUP, DM, DM}; pg8::StaticOrder S; S.init(M, DUP, G, (int)blockIdx.x);
      EpiUp E{(h16*)(ws + WS_UP), DUP, (const float*)(ws + WS_CTL + CTL_SSQ2_OFF), (const float*)(ws + WS_BIAS2), (h16*)(ws + WS_HALO)};
      pg8::gemm_phase<EpiUp, pg8::StaticOrder, true, true>(lds, g, S, E); }
    GRID_BAR();
    {
        h16* UP = (h16*)(ws + WS_UP);
        const int rpb = M / G, row0 = (int)blockIdx.x * rpb;
        const bool act = tid < DFF / 8; const int col = 8 * tid;
        float pg1[8], pg2[8], pv1[8], pv2[8];
#pragma unroll
        for (int e = 0; e < 8; ++e) { pg1[e] = 0.f; pg2[e] = 0.f; pv1[e] = 0.f; pv2[e] = 0.f; }
        if (act && (row0 % SL) != 0) {
            const h16* HL = (const h16*)(ws + WS_HALO) + (size_t)(row0 / 64 - 1) * 2 * DUP;
            const h16x8 a = *(const h16x8*)(HL + DUP + col), bq = *(const h16x8*)(HL + col);
            const h16x8 c = *(const h16x8*)(HL + DUP + DFF + col), d = *(const h16x8*)(HL + DFF + col);
#pragma unroll
            for (int e = 0; e < 8; ++e) { pg1[e] = (float)a[e]; pg2[e] = (float)bq[e]; pv1[e] = (float)c[e]; pv2[e] = (float)d[e]; }
        }
        if (act) {
            float wg[3][8], wv[3][8], bgv[8], bvv[8];
#pragma unroll
            for (int j = 0; j < 3; ++j)
#pragma unroll
                for (int e = 0; e < 8; ++e) { wg[j][e] = p.conv_w[(size_t)j * DUP + col + e]; wv[j][e] = p.conv_w[(size_t)j * DUP + DFF + col + e]; }
#pragma unroll
            for (int e = 0; e < 8; ++e) { bgv[e] = p.conv_b[col + e]; bvv[e] = p.conv_b[DFF + col + e]; }
            for (int t0 = 0; t0 < rpb; t0 += 4) {
                h16x8 gl[4], vl[4];
#pragma unroll
                for (int i = 0; i < 4; ++i) { const h16* rp = UP + (size_t)(row0 + t0 + i) * DUP + col; gl[i] = *(const h16x8*)rp; vl[i] = *(const h16x8*)(rp + DFF); }
#pragma unroll
                for (int i = 0; i < 4; ++i) {
                    float o[8];
#pragma unroll
                    for (int e = 0; e < 8; ++e) { const float gc = (float)gl[i][e], vc = (float)vl[i][e];
                        const float cg_ = bgv[e] + wg[0][e] * pg2[e] + wg[1][e] * pg1[e] + wg[2][e] * gc;
                        const float cv_ = bvv[e] + wv[0][e] * pv2[e] + wv[1][e] * pv1[e] + wv[2][e] * vc;
                        o[e] = gelu_tanh(cg_) * cv_; pg2[e] = pg1[e]; pg1[e] = gc; pv2[e] = pv1[e]; pv1[e] = vc; }
                    u32x4 w; w.x = pkh(o[0], o[1]); w.y = pkh(o[2], o[3]); w.z = pkh(o[4], o[5]); w.w = pkh(o[6], o[7]);
                    *(u32x4*)(UP + (size_t)(row0 + t0 + i) * DUP + col) = w;
                }
            }
        }
    }
    GRID_BAR();
    { pg8::Gemm g{(const h16*)(ws + WS_UP), (const h16*)(ws + WS_WDOWN), M, DM, DFF, DUP}; pg8::StaticOrder S; S.init(M, DM, G, (int)blockIdx.x);
      EpiResid E{p.out, p.out, MOD + 5 * DM};
      pg8::gemm_phase<EpiResid, pg8::StaticOrder, true, true>(lds, g, S, E); }
}

extern "C" void kernel_launch(void* const* d_in, const int* in_sizes, int n_in, void* d_out, int out_size, void* d_ws, size_t ws_size, hipStream_t stream) {
    static int grid = 0;
    if (grid == 0) {
        if (n_in != 27 || in_sizes[0] != M * DM || out_size != M * DM || ws_size < WS_END) { fprintf(stderr, "kernel_launch: unexpected shapes (n_in %d, in0 %d, out %d, ws %zu)\n", n_in, n_in > 0 ? in_sizes[0] : -1, out_size, ws_size); grid = -1; return; }
        int dev = 0, cus = 0, per_cu = 0;
        (void)hipGetDevice(&dev); (void)hipDeviceGetAttribute(&cus, hipDeviceAttributeMultiprocessorCount, dev);
        if (hipFuncSetAttribute((const void*)fwd_mega, hipFuncAttributeMaxDynamicSharedMemorySize, LDS_BYTES) != hipSuccess) { fprintf(stderr, "kernel_launch: hipFuncSetAttribute failed\n"); grid = -1; return; }
        if (hipOccupancyMaxActiveBlocksPerMultiprocessor(&per_cu, (const void*)fwd_mega, NT, LDS_BYTES) != hipSuccess || per_cu < 1) { fprintf(stderr, "kernel_launch: occupancy query reports %d\n", per_cu); grid = -1; return; }
        grid = cus;
        if (grid != 256) { fprintf(stderr, "kernel_launch: built for 256 CUs, got %d\n", grid); grid = -1; return; }
    }
    if (grid < 0) return;
    (void)hipMemsetAsync((char*)d_ws + WS_CTL, 0, CTL_ZERO_BYTES, stream);
    Params p{};
    const float* const* in = (const float* const*)d_in;
    p.x = in[0]; p.c = in[1]; p.positions = (const int*)d_in[2]; p.w_ada = in[3]; p.b_ada = in[4]; p.norm_mix = in[5]; p.w_in = in[6]; p.log_dt = in[7];
    p.a_re = in[8]; p.a_im = in[9]; p.b_re = in[10]; p.b_im = in[11]; p.c_re = in[12]; p.c_im = in[13]; p.ssm_d = in[14]; p.w_glu = in[15]; p.b_glu = in[16];
    p.q_norm = in[17]; p.k_norm = in[18]; p.on_ssm = in[19]; p.on_attn = in[20]; p.w_out = in[21]; p.norm_ffn = in[22]; p.w_up = in[23]; p.conv_w = in[24];
    p.conv_b = in[25]; p.w_down = in[26]; p.out = (float*)d_out; p.ws = (unsigned char*)d_ws; p.use_cg_sync = 0ull;
    void* args[] = {&p};
    const hipError_t e = hipLaunchCooperativeKernel((const void*)fwd_mega, dim3(grid), dim3(NT), args, LDS_BYTES, stream);
    if (e != hipSuccess) fprintf(stderr, "kernel_launch: cooperative launch failed: %s (grid %d)\n", hipGetErrorString(e), grid);
}
```

```cpp
#include <hip/hip_runtime.h>
#include <hip/hip_cooperative_groups.h>
#include <cstdio>
#include <cstdint>
namespace cg = cooperative_groups;

typedef _Float16 h16;
typedef _Float16 h16x8 __attribute__((ext_vector_type(8)));
typedef _Float16 h16x4 __attribute__((ext_vector_type(4)));
typedef _Float16 h16x2 __attribute__((ext_vector_type(2)));
typedef float f32x16 __attribute__((ext_vector_type(16)));
typedef float f32x2 __attribute__((ext_vector_type(2)));
typedef unsigned u32x2_t __attribute__((ext_vector_type(2)));
#define LAS __attribute__((address_space(3)))

namespace pg8 {
#define PG8_LAS __attribute__((address_space(3)))
typedef float f32x4 __attribute__((ext_vector_type(4)));
typedef unsigned u32x4 __attribute__((ext_vector_type(4)));
constexpr int BM = 256, BK = 64, HALF = 128, HTB = HALF * BK * 2  , STAGE_BYTES = 8 * HTB, NXCD = 8, WGM = 8;

__host__ __device__ __forceinline__ int lds_byte(int r, int c) { const int st = (r >> 4) * 2 + (c >> 5), rr = r & 15, cc = c & 31, ob = rr * 64 + cc * 2; return st * 1024 + (ob ^ (((ob >> 9) & 1) << 5)); }
__host__ __device__ __forceinline__ void stage_rc(int b, int& R, int& C) { const int st = b / 1024, sb = b % 1024, swz = sb ^ (((sb >> 9) & 1) << 5); R = (st >> 1) * 16 + swz / 64; C = (st & 1) * 32 + (swz % 64) / 2; }
__host__ __device__ __forceinline__ int perm32(int rho) { const int n = rho >> 4, i = rho & 15; return 8 * (i >> 2) + 4 * n + (i & 3); }

struct Unit { int pm, pn; };
struct Gemm { const h16* A; const h16* Bt; int M, N, K, lda; };

struct StaticOrder {
    int nM, nN, nwg, G, c;
    __host__ __device__ void init(int M, int N, int G_, int c_) { nM = M / BM; nN = N / BM; nwg = nM * nN; G = G_; c = c_; }
    __host__ __device__ bool next(int i, Unit& u) const {
        const long L = (long)i * G + c; if (L >= nwg) return false;
        int wgid = (int)L; { const int q = nwg / NXCD, r = nwg % NXCD, xcd = wgid % NXCD, off = wgid / NXCD; wgid = (xcd < r ? xcd * (q + 1) : r * (q + 1) + (xcd - r) * q) + off; }
        const int nig = WGM * nN, gid = wgid / nig, fm = gid * WGM, gsz = (nM - fm) < WGM ? (nM - fm) : WGM;
        u.pm = fm + ((wgid % nig) % gsz); u.pn = (wgid % nig) / gsz; return true;
    }
    __device__ __forceinline__ void a_ready(const Unit&) const {}
    __device__ __forceinline__ void done(const Unit&) const {}
};

template <class Epi, class Sched, bool ALIGN_EPI = false, bool SP2 = false>
__device__ __forceinline__ void gemm_phase(PG8_LAS unsigned char* lds, const Gemm g, const Sched& S, const Epi& E) {
    int tid = threadIdx.x; asm volatile("" : "+v"(tid));
    const int wid = __builtin_amdgcn_readfirstlane(tid >> 6), lane = tid & 63, wr = wid >> 2, wc = wid & 3, fr = lane & 15, fq = lane >> 4;
    const int K = g.K, lda = g.lda, nt = K / BK;
    unsigned voffA[2], voffB[2];
#pragma unroll
    for (int i = 0; i < 2; ++i) { int R, C; stage_rc(tid * 16 + i * 8192, R, C); const int Rb = Epi::PERM ? ((R & ~31) + perm32(R & 31)) : R;
        const int Ra = Epi::AROW8 ? (128 * (R >> 6) + 8 * (R & 15) + ((R >> 4) & 3)) : R;
        voffA[i] = (unsigned)(Ra * lda + C) * 2u; voffB[i] = (unsigned)(Rb * K + C) * 2u; }
    const size_t kstep = (size_t)(BK * 2);
    const size_t hstepB = (size_t)HALF * K * 2, hstepA = (size_t)(Epi::AROW8 ? 4 : HALF) * lda * 2;
    const size_t tstepA = (size_t)2 * HALF * lda * 2, tstepB = 2 * hstepB;
    const unsigned ldsw = (unsigned)wid * 1024u;
    const int aoff = lds_byte(wr * 64 + fr, fq * 8), boff = lds_byte(wc * 32 + fr, fq * 8);
#define PG8_SA(b, h) (((b) * 2 + (h)) * HTB)
#define PG8_SB(b, h) ((4 + (b) * 2 + (h)) * HTB)
#define PG8_STAGE(bufoff, gbase, voff) do { _Pragma("unroll") for (int _i = 0; _i < 2; ++_i) \
        __builtin_amdgcn_global_load_lds((const unsigned*)((const char*)(gbase) + (voff)[_i]), (PG8_LAS unsigned*)(lds + (bufoff) + ldsw + _i * 8192), 16, 0, 0); } while (0)
#define PG8_LDA(dst, b, h) do { _Pragma("unroll") for (int m = 0; m < 4; ++m) _Pragma("unroll") for (int k = 0; k < 2; ++k) dst[m][k] = *(const PG8_LAS h16x8*)(lds + PG8_SA(b, h) + aoff + m * 2048 + k * 1024); } while (0)
#define PG8_LDB(dst, b, h) do { _Pragma("unroll") for (int n = 0; n < 2; ++n) _Pragma("unroll") for (int k = 0; k < 2; ++k) dst[n][k] = *(const PG8_LAS h16x8*)(lds + PG8_SB(b, h) + boff + n * 2048 + k * 1024); } while (0)
#define PG8_MMA(ai, bj, At, Bt) do { __builtin_amdgcn_s_setprio(1); _Pragma("unroll") for (int m = 0; m < 4; ++m) _Pragma("unroll") for (int n = 0; n < 2; ++n) _Pragma("unroll") for (int k = 0; k < 2; ++k) \
        acc[ai][bj][m][n] = __builtin_amdgcn_mfma_f32_16x16x32_f16(Bt[n][k], At[m][k], acc[ai][bj][m][n], 0, 0, 0); __builtin_amdgcn_s_setprio(0); } while (0)
#define PG8_WAIT_V(n) asm volatile("s_waitcnt vmcnt(" #n ")" ::: "memory")
#define PG8_WAIT_L(n) asm volatile("s_waitcnt lgkmcnt(" #n ")" ::: "memory")
#define PG8_BAR __builtin_amdgcn_s_barrier()
#define PG8_SCHED __builtin_amdgcn_sched_barrier(0)
    Unit cur, nxt; int ui = 0;
    if (!S.next(0, cur)) return;
    f32x4 acc[2][2][4][2];
#pragma unroll
    for (int a = 0; a < 2; ++a)
#pragma unroll
        for (int b = 0; b < 2; ++b)
#pragma unroll
            for (int m = 0; m < 4; ++m)
#pragma unroll
                for (int n = 0; n < 2; ++n) acc[a][b][m][n] = (f32x4){0.f, 0.f, 0.f, 0.f};
    h16x8 At[4][2], B0[2][2], B1[2][2];
    const char* cA = (const char*)g.A + (size_t)cur.pm * tstepA; const char* cB = (const char*)g.Bt + (size_t)cur.pn * tstepB;
    S.a_ready(cur);
    if constexpr (SP2) {
        PG8_STAGE(PG8_SB(0, 0), cB, voffB); PG8_STAGE(PG8_SB(0, 1), cB + hstepB, voffB); PG8_STAGE(PG8_SA(0, 0), cA, voffA); PG8_STAGE(PG8_SA(0, 1), cA + hstepA, voffA);
        if (wr == 1) PG8_BAR;
        PG8_WAIT_V(2); PG8_BAR;
        PG8_STAGE(PG8_SB(1, 0), cB + kstep, voffB); PG8_STAGE(PG8_SA(1, 0), cA + kstep, voffA); PG8_STAGE(PG8_SB(1, 1), cB + hstepB + kstep, voffB);
        PG8_WAIT_V(6); PG8_BAR;
    } else {
        PG8_STAGE(PG8_SB(0, 0), cB, voffB); PG8_STAGE(PG8_SA(0, 0), cA, voffA); PG8_STAGE(PG8_SB(0, 1), cB + hstepB, voffB); PG8_STAGE(PG8_SA(0, 1), cA + hstepA, voffA);
        if (wr == 1) PG8_BAR;
        PG8_WAIT_V(4); PG8_BAR;
        PG8_STAGE(PG8_SB(1, 0), cB + kstep, voffB); PG8_STAGE(PG8_SA(1, 0), cA + kstep, voffA); PG8_STAGE(PG8_SB(1, 1), cB + hstepB + kstep, voffB);
        PG8_WAIT_V(6); PG8_BAR;
    }
    for (;;) {
        const bool has_next = S.next(ui + 1, nxt);
        const char* nA = has_next ? (const char*)g.A + (size_t)nxt.pm * tstepA : cA; const char* nB = has_next ? (const char*)g.Bt + (size_t)nxt.pn * tstepB : cB;
        for (int t = 0; t < nt; t += 2) {
            if constexpr (Epi::MIDK_T >= 0) { if (t == Epi::MIDK_T) E.midk(acc, cur, wr, wc, fr, fq); }
            const bool last = (t == nt - 2);
            const char* a1 = cA + (size_t)(t + 1) * kstep;
            const char* a2 = last ? nA : cA + (size_t)(t + 2) * kstep; const char* b2 = last ? nB : cB + (size_t)(t + 2) * kstep;
            const char* a3 = a2 + kstep; const char* b3 = b2 + kstep;
            if (last && has_next) S.a_ready(nxt);
            if constexpr (SP2) {
            PG8_LDB(B0, 0, 0); PG8_LDB(B1, 0, 1); PG8_SCHED; PG8_LDA(At, 0, 0); PG8_STAGE(PG8_SA(1, 1), a1 + hstepA, voffA);
            PG8_WAIT_V(8); PG8_WAIT_L(0); PG8_BAR; PG8_MMA(0, 0, At, B0); PG8_MMA(0, 1, At, B1); PG8_BAR; PG8_SCHED;
            PG8_LDA(At, 0, 1); PG8_STAGE(PG8_SB(0, 0), b2, voffB); PG8_STAGE(PG8_SB(0, 1), b2 + hstepB, voffB); PG8_STAGE(PG8_SA(0, 0), a2, voffA);
            PG8_WAIT_V(8); PG8_WAIT_L(0); PG8_BAR; PG8_MMA(1, 0, At, B0); PG8_MMA(1, 1, At, B1); PG8_BAR; PG8_SCHED;
            PG8_LDB(B0, 1, 0); PG8_LDB(B1, 1, 1); PG8_SCHED; PG8_LDA(At, 1, 0); PG8_STAGE(PG8_SA(0, 1), a2 + hstepA, voffA);
            PG8_WAIT_V(8); PG8_WAIT_L(0); PG8_BAR; PG8_MMA(0, 0, At, B0); PG8_MMA(0, 1, At, B1); PG8_BAR; PG8_SCHED;
            PG8_LDA(At, 1, 1); PG8_STAGE(PG8_SB(1, 0), b3, voffB); PG8_STAGE(PG8_SB(1, 1), b3 + hstepB, voffB); PG8_STAGE(PG8_SA(1, 0), a3, voffA);
            PG8_WAIT_V(8); PG8_WAIT_L(0); PG8_BAR; PG8_MMA(1, 0, At, B0); PG8_MMA(1, 1, At, B1); PG8_BAR; PG8_SCHED;
            } else {
            PG8_LDB(B0, 0, 0); PG8_SCHED; PG8_LDA(At, 0, 0); PG8_STAGE(PG8_SA(1, 1), a1 + hstepA, voffA);
            PG8_WAIT_L(8); PG8_BAR; PG8_WAIT_L(0); PG8_MMA(0, 0, At, B0); PG8_BAR; PG8_SCHED;
            PG8_LDB(B1, 0, 1); PG8_STAGE(PG8_SB(0, 0), b2, voffB);
            PG8_BAR; PG8_WAIT_L(0); PG8_MMA(0, 1, At, B1); PG8_BAR;
            PG8_LDA(At, 0, 1); PG8_STAGE(PG8_SA(0, 0), a2, voffA);
            PG8_BAR; PG8_WAIT_L(0); PG8_MMA(1, 0, At, B0); PG8_BAR; PG8_SCHED;
            PG8_STAGE(PG8_SB(0, 1), b2 + hstepB, voffB);
            PG8_WAIT_V(6); PG8_BAR; PG8_MMA(1, 1, At, B1); PG8_BAR;
            PG8_LDB(B0, 1, 0); PG8_SCHED; PG8_LDA(At, 1, 0); PG8_STAGE(PG8_SA(0, 1), a2 + hstepA, voffA);
            PG8_WAIT_L(8); PG8_BAR; PG8_WAIT_L(0); PG8_MMA(0, 0, At, B0); PG8_BAR; PG8_SCHED;
            PG8_LDB(B1, 1, 1); PG8_STAGE(PG8_SB(1, 0), b3, voffB);
            PG8_BAR; PG8_WAIT_L(0); PG8_MMA(0, 1, At, B1); PG8_BAR;
            PG8_LDA(At, 1, 1); PG8_STAGE(PG8_SA(1, 0), a3, voffA);
            PG8_BAR; PG8_WAIT_L(0); PG8_MMA(1, 0, At, B0); PG8_BAR; PG8_SCHED;
            PG8_STAGE(PG8_SB(1, 1), b3 + hstepB, voffB);
            PG8_WAIT_V(6); PG8_BAR; PG8_MMA(1, 1, At, B1); PG8_BAR;
            }
        }
        if constexpr (ALIGN_EPI) { if (wr == 0) PG8_BAR; }
        if constexpr (!Epi::AFTER_DRAIN) { E(acc, cur, wr, wc, fr, fq); S.done(cur); }
        if (!has_next) break;
#pragma unroll
        for (int a = 0; a < 2; ++a)
#pragma unroll
            for (int b = 0; b < 2; ++b)
#pragma unroll
                for (int m = 0; m < 4; ++m)
#pragma unroll
                    for (int n = 0; n < 2; ++n) acc[a][b][m][n] = (f32x4){0.f, 0.f, 0.f, 0.f};
        cur = nxt; cA = nA; cB = nB; ++ui;
        if constexpr (ALIGN_EPI) { if (wr == 1) PG8_BAR; }
    }
    PG8_WAIT_V(0);
    if constexpr (!ALIGN_EPI) { if (wr == 0) PG8_BAR; }
    PG8_BAR;
    if constexpr (Epi::AFTER_DRAIN) { E.fused(acc, cur, wr, wc, fr, fq, lds, wid, lane); S.done(cur); }
#undef PG8_SA
#undef PG8_SB
#undef PG8_STAGE
#undef PG8_LDA
#undef PG8_LDB
#undef PG8_MMA
#undef PG8_WAIT_V
#undef PG8_WAIT_L
#undef PG8_BAR
#undef PG8_SCHED
}
}

constexpr int NB = 4, SL = 4096, DM = 1024, M = NB * SL;
constexpr int DSSM = 512, NG = 32, NCH = 16, NP = 64, NH = 8, HD = 64, DATT = 512;
constexpr int NPROJ = 2632, NPROJ_PAD = 2816, DFF = 2816, DUP = 2 * DFF, NMOD = 6 * DM;
constexpr int TOPK = 256;
constexpr float EPS = 1e-6f;
constexpr float QSCALE = 0.125f * 1.4426950408889634f;
constexpr float WI_SCALE = 0.04419417382415922f;
constexpr int NT = 512, NWAVES = 8;
constexpr int LDS_BYTES = 150528;

constexpr size_t MiB = 1u << 20;
constexpr size_t WS_CTL = 0, CTL_ZERO_BYTES = 1 * MiB;
constexpr size_t CTL_MOD_OFF = 512 * 1024;
constexpr size_t CTL_SSQS_OFF = 320 * 1024, CTL_SSQA_OFF = 384 * 1024;
constexpr size_t CTL_SSQ2_OFF = 256 * 1024;
constexpr size_t WS_WIN = 2 * MiB;
constexpr size_t WS_WGLU = WS_WIN + (size_t)NPROJ_PAD * DM * 2;
constexpr size_t WS_WOUT = 8 * MiB;
constexpr size_t WS_WUP = 10 * MiB;
constexpr size_t WS_WDOWN = 21 * MiB;
constexpr size_t WS_BIAS2 = 26 * MiB + 512 * 1024;
constexpr size_t WS_ROPE = 27 * MiB;
constexpr size_t WS_HN = 32 * MiB;
constexpr size_t WS_U = 64 * MiB, WS_Q = 80 * MiB, WS_K = 96 * MiB, WS_V = 112 * MiB, WS_QI = 128 * MiB;
constexpr size_t WS_KI = 144 * MiB;
constexpr size_t WS_KIF = 147 * MiB;
constexpr size_t WS_WI = 146 * MiB;
constexpr size_t WS_VT = 147 * MiB;
constexpr size_t WS_MASK = 163 * MiB;
constexpr size_t WS_YS = 171 * MiB;
constexpr size_t WS_YMIX = 187 * MiB;
constexpr size_t WS_YG = 219 * MiB;
constexpr size_t WS_YA = 235 * MiB;
constexpr size_t WS_WST = 219 * MiB;
constexpr size_t WS_WOT = 223 * MiB;
constexpr size_t WS_KT = 227 * MiB;
constexpr size_t WS_L32 = 227 * MiB + 512 * 1024;
constexpr size_t WS_UP = 64 * MiB;
constexpr size_t WS_HALO = 240 * MiB;
constexpr size_t WS_H1 = 152 * MiB;
constexpr size_t WS_END = 256 * MiB;
static_assert(WS_Q == WS_U + 16 * MiB && WS_K == WS_U + 32 * MiB && WS_V == WS_U + 48 * MiB && WS_QI == WS_U + 64 * MiB, "EpiProj addresses U|Q|K|V|QI by tile pair");
static_assert(WS_UP + (size_t)M * DUP * 2 <= WS_END && WS_YA + (size_t)M * 512 * 2 <= WS_END, "ws map");
constexpr int CW_Q4 = 64;
constexpr int CW_BAR = 4096;

struct Params {
    const float *x, *c, *w_ada, *b_ada, *norm_mix, *w_in, *log_dt, *a_re, *a_im, *b_re, *b_im, *c_re, *c_im, *ssm_d, *w_glu, *b_glu,
                *q_norm, *k_norm, *on_ssm, *on_attn, *w_out, *norm_ffn, *w_up, *conv_w, *conv_b, *w_down;
    const int* positions;
    float* out;
    unsigned char* ws;
    unsigned long long use_cg_sync;
};

__device__ __forceinline__ unsigned pkh(float a, float b) { h16x2 v = {(h16)a, (h16)b}; return __builtin_bit_cast(unsigned, v); }
__device__ __forceinline__ float wave_sum(float v) {
#pragma unroll
    for (int o = 1; o < 64; o <<= 1) v += __shfl_xor(v, o);
    return v;
}
__device__ __forceinline__ float fexp2(float x) { return __builtin_amdgcn_exp2f(x); }
__device__ __forceinline__ float frcp(float x) { return __builtin_amdgcn_rcpf(x); }
__device__ __forceinline__ float rows4_sum(float v) {
    const auto a_ = __builtin_amdgcn_permlane16_swap(__float_as_uint(v), __float_as_uint(v), false, false); v = __uint_as_float(a_[0]) + __uint_as_float(a_[1]);
    const auto b_ = __builtin_amdgcn_permlane32_swap(__float_as_uint(v), __float_as_uint(v), false, false); return __uint_as_float(b_[0]) + __uint_as_float(b_[1]); }
__device__ __forceinline__ float frsq(float x) { return __builtin_amdgcn_rsqf(x); }
__device__ __forceinline__ float sigmoidf_(float z) { return frcp(1.0f + fexp2(-1.4426950408889634f * z)); }
__device__ __forceinline__ float gelu_tanh(float x) {
    const float inner = 0.7978845608028654f * (x + 0.044715f * x * x * x);
    return x * frcp(1.0f + fexp2(-2.8853900817779268f * inner));
}
__device__ __forceinline__ int crow(int r, int hi) { return (r & 3) + 8 * (r >> 2) + 4 * hi; }
__device__ __forceinline__ void lds_barrier() { asm volatile("s_waitcnt lgkmcnt(0)\n\ts_barrier" ::: "memory"); }

using pg8::f32x4; using pg8::u32x4;
struct EpiStoreH {
    static constexpr bool PERM = true, AFTER_DRAIN = false, AROW8 = false; static constexpr int MIDK_T = -1;
    h16* O; int ldc;
    __device__ __forceinline__ void operator()(const f32x4 (&acc)[2][2][4][2], const pg8::Unit& u, int wr, int wc, int fr, int fq) const {
        const int row0 = u.pm * 256 + wr * 64 + fr, col0 = u.pn * 256 + wc * 32 + 8 * fq;
#pragma unroll
        for (int ai = 0; ai < 2; ++ai)
#pragma unroll
            for (int m = 0; m < 4; ++m) { h16* rowp = O + (size_t)(row0 + ai * 128 + m * 16) * ldc + col0;
#pragma unroll
                for (int bj = 0; bj < 2; ++bj) { const f32x4 v0 = acc[ai][bj][m][0], v1 = acc[ai][bj][m][1];
                    u32x4 w; w.x = pkh(v0[0], v0[1]); w.y = pkh(v0[2], v0[3]); w.z = pkh(v1[0], v1[1]); w.w = pkh(v1[2], v1[3]);
                    *(u32x4*)(rowp + bj * 128) = w; } }
    }
};
struct EpiProj {
    static constexpr bool PERM = true, AFTER_DRAIN = false, AROW8 = false; static constexpr int MIDK_T = -1;
    h16 *U, *Q, *K, *V, *QI, *KIF; float* WI; const float* RC; const float* RS; const float* qn; const float* kn;
    __device__ __forceinline__ void operator()(const f32x4 (&acc)[2][2][4][2], const pg8::Unit& u, int wr, int wc, int fr, int fq) const {
        int row0 = u.pm * 256 + wr * 64 + fr; asm volatile("" : "+v"(row0));
        const int pn = u.pn;
        if (pn < 2 || pn == 6 || pn == 7) {
            h16* dst = (h16*)((unsigned char*)U + (size_t)(pn >> 1) * (16u << 20)); const int cc0 = (pn & 1) * 256 + wc * 32 + 8 * fq;
#pragma unroll
            for (int bj = 0; bj < 2; ++bj)
#pragma unroll
                for (int ai = 0; ai < 2; ++ai)
#pragma unroll
                    for (int m = 0; m < 4; ++m) { const int row = row0 + ai * 128 + m * 16; const f32x4 v0 = acc[ai][bj][m][0], v1 = acc[ai][bj][m][1];
                        u32x4 w; w.x = pkh(v0[0], v0[1]); w.y = pkh(v0[2], v0[3]); w.z = pkh(v1[0], v1[1]); w.w = pkh(v1[2], v1[3]);
                        *(u32x4*)(dst + (size_t)row * 512 + cc0 + bj * 128) = w; }
            return;
        }
        if (pn == 10 && wc >= 2) return;
        if (pn == 10 && wc == 1) {
            if (fq == 0) {
#pragma unroll
                for (int ai = 0; ai < 2; ++ai)
#pragma unroll
                    for (int m = 0; m < 4; ++m) { float* wp = WI + (size_t)(row0 + ai * 128 + m * 16) * 8; *(f32x4*)wp = acc[ai][0][m][0] * WI_SCALE; *(f32x4*)(wp + 4) = acc[ai][0][m][1] * WI_SCALE; } }
            return;
        }
        const bool isq = (pn == 2 || pn == 3), isk = (pn == 4 || pn == 5);
        if (isq || isk) head_rows<0>(acc, row0, pn, wc, fq, isk ? kn : qn, isq ? QSCALE : 1.0f);
        else if (pn == 10) head_rows<2>(acc, row0, pn, wc, fq, qn, 1.0f);
        else head_rows<1>(acc, row0, pn, wc, fq, qn, 1.0f);
    }
    template <int KIND> __device__ __forceinline__ void head_rows(const f32x4 (&acc)[2][2][4][2], int row0, int pn, int wc, int fq, const float* nw, float scale) const {
        f32x4 g0a = {1.f, 1.f, 1.f, 1.f}, g0b = g0a, g1a = g0a, g1b = g0a;
        if (KIND == 0) { g0a = *(const f32x4*)(nw + 8 * fq); g0b = *(const f32x4*)(nw + 8 * fq + 4); g1a = *(const f32x4*)(nw + 32 + 8 * fq); g1b = *(const f32x4*)(nw + 32 + 8 * fq + 4); }
        h16* dst = (h16*)((unsigned char*)U + (size_t)(pn >> 1) * (16u << 20)); const int hcol = ((pn & 1) * 4 + wc) * 64 + 8 * fq;
#pragma unroll
        for (int ai = 0; ai < 2; ++ai)
#pragma unroll
            for (int m = 0; m < 4; ++m) {
                const int row = row0 + ai * 128 + m * 16;
                f32x4 x1a = acc[ai][0][m][0], x1b = acc[ai][0][m][1], x2a = acc[ai][1][m][0], x2b = acc[ai][1][m][1];
                if (KIND == 0) {
                    float ss = 0.f;
#pragma unroll
                    for (int e = 0; e < 4; ++e) ss += x1a[e] * x1a[e] + x1b[e] * x1b[e] + x2a[e] * x2a[e] + x2b[e] * x2b[e];
                    ss = rows4_sum(ss);
                    const float rstd = frsq(ss * (1.0f / 64.0f) + EPS);
                    x1a = x1a * rstd * g0a; x1b = x1b * rstd * g0b; x2a = x2a * rstd * g1a; x2b = x2b * rstd * g1b;
                }
                const f32x4 ca = *(const f32x4*)(RC + (size_t)row * 32 + 8 * fq), cb = *(const f32x4*)(RC + (size_t)row * 32 + 8 * fq + 4);
                const f32x4 sa = *(const f32x4*)(RS + (size_t)row * 32 + 8 * fq), sb = *(const f32x4*)(RS + (size_t)row * 32 + 8 * fq + 4);
                const f32x4 y1a = (x1a * ca - x2a * sa) * scale, y1b = (x1b * cb - x2b * sb) * scale, y2a = (x1a * sa + x2a * ca) * scale, y2b = (x1b * sb + x2b * cb) * scale;
                u32x4 w1, w2; w1.x = pkh(y1a[0], y1a[1]); w1.y = pkh(y1a[2], y1a[3]); w1.z = pkh(y1b[0], y1b[1]); w1.w = pkh(y1b[2], y1b[3]);
                w2.x = pkh(y2a[0], y2a[1]); w2.y = pkh(y2a[2], y2a[3]); w2.z = pkh(y2b[0], y2b[1]); w2.w = pkh(y2b[2], y2b[3]);
                if (KIND == 2) {
                    const int bb = row / SL, key = row % SL; h16* kf = KIF + ((size_t)(bb * (SL / 16) + (key >> 4)) * 8) * 128 + (key & 15) * 8;
                    *(u32x4*)(kf + fq * 128) = w1; *(u32x4*)(kf + (4 + fq) * 128) = w2;
                } else { h16* rp = dst + (size_t)row * 512 + hcol; *(u32x4*)rp = w1; *(u32x4*)(rp + 32) = w2; }
            }
    }
};
struct EpiGlu {
    static constexpr bool PERM = true, AFTER_DRAIN = false, AROW8 = false; static constexpr int MIDK_T = -1;
    const h16* YS; h16* YO; const float* bias; float* SSQ;
    __device__ __forceinline__ void operator()(const f32x4 (&acc)[2][2][4][2], const pg8::Unit& u, int wr, int wc, int fr, int fq) const {
        const int row0 = u.pm * 256 + wr * 64 + fr, col0 = u.pn * 256 + wc * 32 + 8 * fq;
        float ss[2][4];
#pragma unroll
        for (int ai = 0; ai < 2; ++ai)
#pragma unroll
            for (int m = 0; m < 4; ++m) ss[ai][m] = 0.f;
#pragma unroll
        for (int bj = 0; bj < 2; ++bj) { const int c0 = col0 + bj * 128;
            const f32x4 b0 = *(const f32x4*)(bias + c0), b1 = *(const f32x4*)(bias + c0 + 4);
#pragma unroll
            for (int ai = 0; ai < 2; ++ai)
#pragma unroll
                for (int m = 0; m < 4; ++m) { const size_t row = (size_t)(row0 + ai * 128 + m * 16);
                    const h16x8 y = __builtin_nontemporal_load((const h16x8*)(YS + row * 512 + c0)); const f32x4 z0 = acc[ai][bj][m][0] + b0, z1 = acc[ai][bj][m][1] + b1;
                    float o[8];
#pragma unroll
                    for (int e = 0; e < 4; ++e) { o[e] = (float)y[e] * sigmoidf_(z0[e]); o[4 + e] = (float)y[4 + e] * sigmoidf_(z1[e]); }
#pragma unroll
                    for (int e = 0; e < 8; ++e) ss[ai][m] += o[e] * o[e];
                    u32x4 w; w.x = pkh(o[0], o[1]); w.y = pkh(o[2], o[3]); w.z = pkh(o[4], o[5]); w.w = pkh(o[6], o[7]);
                    *(u32x4*)(YO + row * DM + c0) = w; } }
#pragma unroll
        for (int ai = 0; ai < 2; ++ai)
#pragma unroll
            for (int m = 0; m < 4; ++m) { float v = ss[ai][m]; v += __shfl_xor(v, 16); v += __shfl_xor(v, 32);
                if (fq == 0) atomicAdd(SSQ + row0 + ai * 128 + m * 16, v); }
    }
};
struct EpiResid {
    static constexpr bool PERM = true, AFTER_DRAIN = false, AROW8 = false; static constexpr int MIDK_T = -1;
    const h16* base; float* out; const float* gate;
    __device__ __forceinline__ void operator()(const f32x4 (&acc)[2][2][4][2], const pg8::Unit& u, int wr, int wc, int fr, int fq) const {
        const int row0 = u.pm * 256 + wr * 64 + fr, col0 = u.pn * 256 + wc * 32 + 8 * fq;
        const float* gp = gate + (size_t)((u.pm * 256) / SL) * NMOD;
#pragma unroll
        for (int bj = 0; bj < 2; ++bj) { const int c0 = col0 + bj * 128;
            const f32x4 g0 = *(const f32x4*)(gp + c0), g1 = *(const f32x4*)(gp + c0 + 4);
#pragma unroll
            for (int ai = 0; ai < 2; ++ai)
#pragma unroll
                for (int m = 0; m < 4; ++m) { const size_t off = (size_t)(row0 + ai * 128 + m * 16) * DM + c0;
                    const h16x8 xb = __builtin_nontemporal_load((const h16x8*)(base + off));
                    const f32x4 x0 = {(float)xb[0], (float)xb[1], (float)xb[2], (float)xb[3]}, x1 = {(float)xb[4], (float)xb[5], (float)xb[6], (float)xb[7]};
                    __builtin_nontemporal_store(x0 + g0 * acc[ai][bj][m][0], (f32x4*)(out + off)); __builtin_nontemporal_store(x1 + g1 * acc[ai][bj][m][1], (f32x4*)(out + off + 4)); } }
    }
};

struct EpiResidNorm {
    static constexpr bool PERM = true, AFTER_DRAIN = false, AROW8 = false; static constexpr int MIDK_T = 8;
    const float* base; h16* out; const float* gate; const float* nw; const float* sc; h16* A2; float* SSQ; const float* SSQS; const float* SSQA;
    __device__ __forceinline__ void midk(f32x4 (&acc)[2][2][4][2], const pg8::Unit& u, int wr, int wc, int fr, int fq) const {
        int row0 = u.pm * 256 + wr * 64 + fr; asm volatile("" : "+v"(row0));
#pragma unroll
        for (int ai = 0; ai < 2; ++ai)
#pragma unroll
            for (int m = 0; m < 4; ++m) { const int row = row0 + ai * 128 + m * 16;
                const float qa_ = SSQA[row] * (1.0f / 512.0f) + EPS; float f = (qa_ * frsq(qa_)) * frsq(SSQS[row] * (1.0f / 512.0f) + EPS);
                asm volatile("" : "+v"(f) :: "memory");
#pragma unroll
                for (int bj = 0; bj < 2; ++bj) { acc[ai][bj][m][0] *= f; acc[ai][bj][m][1] *= f; }
                asm volatile("" : "+v"(acc[ai][0][m][0]), "+v"(acc[ai][0][m][1]), "+v"(acc[ai][1][m][0]), "+v"(acc[ai][1][m][1]) :: "memory"); }
    }
    __device__ __forceinline__ void operator()(const f32x4 (&acc)[2][2][4][2], const pg8::Unit& u, int wr, int wc, int fr, int fq) const {
        const int row0 = u.pm * 256 + wr * 64 + fr, col0 = u.pn * 256 + wc * 32 + 8 * fq;
        const size_t boff = (size_t)((u.pm * 256) / SL) * NMOD;
        float ss[2][4];
#pragma unroll
        for (int ai = 0; ai < 2; ++ai)
#pragma unroll
            for (int m = 0; m < 4; ++m) ss[ai][m] = 0.f;
#pragma unroll
        for (int bj = 0; bj < 2; ++bj) { const int c0 = col0 + bj * 128;
            const f32x4 g0 = *(const f32x4*)(gate + boff + c0), g1 = *(const f32x4*)(gate + boff + c0 + 4);
            const f32x4 s0 = (*(const f32x4*)(sc + boff + c0) + 1.0f) * *(const f32x4*)(nw + c0), s1 = (*(const f32x4*)(sc + boff + c0 + 4) + 1.0f) * *(const f32x4*)(nw + c0 + 4);
#pragma unroll
            for (int ai = 0; ai < 2; ++ai)
#pragma unroll
                for (int m = 0; m < 4; ++m) { const size_t off = (size_t)(row0 + ai * 128 + m * 16) * DM + c0;
                    const float ra = frsq(SSQA[row0 + ai * 128 + m * 16] * (1.0f / 512.0f) + EPS);
                    const f32x4 h0 = __builtin_nontemporal_load((const f32x4*)(base + off)) + g0 * (acc[ai][bj][m][0] * ra), h1 = __builtin_nontemporal_load((const f32x4*)(base + off + 4)) + g1 * (acc[ai][bj][m][1] * ra);
                    { u32x4 hw; hw.x = pkh(h0[0], h0[1]); hw.y = pkh(h0[2], h0[3]); hw.z = pkh(h1[0], h1[1]); hw.w = pkh(h1[2], h1[3]); *(u32x4*)(out + off) = hw; }
                    ss[ai][m] += (h0[0] * h0[0] + h0[1] * h0[1]) + (h0[2] * h0[2] + h0[3] * h0[3]) + (h1[0] * h1[0] + h1[1] * h1[1]) + (h1[2] * h1[2] + h1[3] * h1[3]);
                    const f32x4 a0 = h0 * s0, a1 = h1 * s1;
                    u32x4 w; w.x = pkh(a0[0], a0[1]); w.y = pkh(a0[2], a0[3]); w.z = pkh(a1[0], a1[1]); w.w = pkh(a1[2], a1[3]);
                    *(u32x4*)(A2 + off) = w; } }
#pragma unroll
        for (int ai = 0; ai < 2; ++ai)
#pragma unroll
            for (int m = 0; m < 4; ++m) { float v = ss[ai][m]; v += __shfl_xor(v, 16); v += __shfl_xor(v, 32);
                if (fq == 0) atomicAdd(SSQ + row0 + ai * 128 + m * 16, v); }
    }
};
struct EpiUp {
    static constexpr bool PERM = true, AFTER_DRAIN = false, AROW8 = false; static constexpr int MIDK_T = -1;
    h16* O; int ldc; const float* SSQ; const float* bias; h16* HALO;
    __device__ __forceinline__ void operator()(const f32x4 (&acc)[2][2][4][2], const pg8::Unit& u, int wr, int wc, int fr, int fq) const {
        const int row0 = u.pm * 256 + wr * 64 + fr, col0 = u.pn * 256 + wc * 32 + 8 * fq;
        const float* bp = bias + (size_t)((u.pm * 256) / SL) * ldc;
        f32x4 bv[2][2];
#pragma unroll
        for (int bj = 0; bj < 2; ++bj) { bv[bj][0] = *(const f32x4*)(bp + col0 + bj * 128); bv[bj][1] = *(const f32x4*)(bp + col0 + bj * 128 + 4); }
#pragma unroll
        for (int ai = 0; ai < 2; ++ai)
#pragma unroll
            for (int m = 0; m < 4; ++m) { const int row = row0 + ai * 128 + m * 16; const float rstd = 1.0f / sqrtf(SSQ[row] * (1.0f / DM) + EPS);
                h16* rowp = O + (size_t)row * ldc + col0;
#pragma unroll
                for (int bj = 0; bj < 2; ++bj) { const f32x4 v0 = acc[ai][bj][m][0] * rstd + bv[bj][0], v1 = acc[ai][bj][m][1] * rstd + bv[bj][1];
                    u32x4 w; w.x = pkh(v0[0], v0[1]); w.y = pkh(v0[2], v0[3]); w.z = pkh(v1[0], v1[1]); w.w = pkh(v1[2], v1[3]);
                    *(u32x4*)(rowp + bj * 128) = w;
                    if (m == 3 && fr >= 14) *(u32x4*)(HALO + ((size_t)(row >> 6) * 2 + (fr - 14)) * ldc + col0 + bj * 128) = w; } }
    }
};

struct EpiUpConv {
    static constexpr bool PERM = true, AFTER_DRAIN = false, AROW8 = true; static constexpr int MIDK_T = -1;
    h16* A2; const float* SSQ; const float* bias; h16* SB; const float* cw; const float* cb;
    static __device__ __forceinline__ f32x4 shr1(const f32x4& v) { f32x4 r;
#pragma unroll
        for (int e = 0; e < 4; ++e) r[e] = __int_as_float(__builtin_amdgcn_update_dpp(0, __float_as_int(v[e]), 0x111, 0xF, 0xF, true));
        return r; }
    static __device__ __forceinline__ u32x2_t pk4(const f32x4& v) { u32x2_t w; w.x = pkh(v[0], v[1]); w.y = pkh(v[2], v[3]); return w; }
    __device__ __forceinline__ void operator()(const f32x4 (&acc)[2][2][4][2], const pg8::Unit& u, int wr, int wc, int fr, int fq) const {
        int tok0 = u.pm * 256 + wr * 128 + 8 * fr; asm volatile("" : "+v"(tok0));
        const int pcol = u.pn * 256 + wc * 32 + 8 * fq, lcol = u.pn * 128 + wc * 32 + 8 * fq, grp = 2 * u.pm + wr;
        const float* bp = bias + (size_t)((u.pm * 256) / SL) * DUP;
        float rstd[8];
#pragma unroll
        for (int j = 0; j < 8; ++j) rstd[j] = frsq(SSQ[tok0 + j] * (1.0f / DM) + EPS);
#pragma unroll
        for (int n = 0; n < 2; ++n) {
            const int lc = lcol + 4 * n, pc = pcol + 4 * n;
            const f32x4 bg = *(const f32x4*)(bp + pc), bv = *(const f32x4*)(bp + pc + 128);
            const f32x4 wg0 = *(const f32x4*)(cw + lc), wg1 = *(const f32x4*)(cw + DUP + lc), wg2 = *(const f32x4*)(cw + 2 * DUP + lc), cbg = *(const f32x4*)(cb + lc);
            const f32x4 wv0 = *(const f32x4*)(cw + DFF + lc), wv1 = *(const f32x4*)(cw + DUP + DFF + lc), wv2 = *(const f32x4*)(cw + 2 * DUP + DFF + lc), cbv = *(const f32x4*)(cb + DFF + lc);
#define UPG(j) (acc[(j) >> 2][0][(j) & 3][n] * rstd[j] + bg)
#define UPV(j) (acc[(j) >> 2][1][(j) & 3][n] * rstd[j] + bv)
            f32x4 gp2, gp1, vp2, vp1;
            { const f32x4 g6 = UPG(6), g7 = UPG(7), v6 = UPV(6), v7 = UPV(7); gp2 = shr1(g6); gp1 = shr1(g7); vp2 = shr1(v6); vp1 = shr1(v7);
              if (fr == 15 && grp + 1 < M / 128) { h16* sb = SB + ((size_t)(grp + 1) * 4) * DUP + pc;
                  *(u32x2_t*)sb = pk4(g6); *(u32x2_t*)(sb + 128) = pk4(v6); *(u32x2_t*)(sb + DUP) = pk4(g7); *(u32x2_t*)(sb + DUP + 128) = pk4(v7); } }
#pragma unroll
            for (int j = 0; j < 8; ++j) {
                const f32x4 gc = UPG(j), vc = UPV(j);
                if (j < 2 && fr == 0) { h16* sb = SB + ((size_t)grp * 4 + 2 + j) * DUP + pc; *(u32x2_t*)sb = pk4(gc); *(u32x2_t*)(sb + 128) = pk4(vc); }
                const f32x4 cg_ = cbg + wg0 * gp2 + wg1 * gp1 + wg2 * gc, cv_ = cbv + wv0 * vp2 + wv1 * vp1 + wv2 * vc;
                f32x4 o;
#pragma unroll
                for (int e = 0; e < 4; ++e) o[e] = gelu_tanh(cg_[e]) * cv_[e];
                gp2 = gp1; gp1 = gc; vp2 = vp1; vp1 = vc;
                if (j >= 2 || fr != 0) *(u32x2_t*)(A2 + (size_t)(tok0 + j) * DFF + lc) = pk4(o);
            }
#undef UPG
#undef UPV
        }
    }
};

__host__ __device__ __forceinline__ int win_prow(int n) {
    if (n < 512 || (n >= 1536 && n < 2048)) return n;
    if (n < 2560) { const int T = n & ~255, L = n & 255; return T + 128 * ((L >> 5) & 1) + 32 * (L >> 6) + (L & 31); }
    if (n < 2624) { const int d = n - 2560; return 2560 + 128 * (d >> 5) + (d & 31); }
    return 2560 + 32 + (n - 2624);
}
__host__ __device__ __forceinline__ int up_prow(int n) { const int bj = n / DFF, rem = n % DFF; return 256 * (rem >> 7) + 128 * bj + (rem & 127); }
__device__ __forceinline__ void transpose_item(const float* W, int K, int N, h16* WT, LAS float* scr, int item, int lane, const float* ks0 = nullptr, const float* ks1 = nullptr, int winperm = 0) {
    const int nblk = (N + 31) / 32, kb = item / nblk, nb = item % nblk, k0 = 64 * kb, n0 = 32 * nb;
    const int nn = n0 + (lane & 31);
    float vv[32];
#pragma unroll
    for (int i = 0; i < 32; ++i) { const int kk = 2 * i + (lane >> 5); vv[i] = (nn < N) ? __builtin_nontemporal_load(W + (size_t)(k0 + kk) * N + nn) : 0.f; }
#pragma unroll
    for (int i = 0; i < 32; ++i) { const int kk = 2 * i + (lane >> 5); float v = vv[i];
        if (ks0) { const int kg = k0 + kk; v *= (kg < 512) ? ks0[kg] : ks1[kg - 512]; }
        scr[kk * 33 + (lane & 31)] = v; }
    asm volatile("s_waitcnt lgkmcnt(0)" ::: "memory");
    const int c = lane & 7;
#pragma unroll
    for (int j = 0; j < 4; ++j) { const int n = (lane >> 3) + 8 * j; const LAS float* s = scr + (8 * c) * 33 + n;
        u32x4 o; o.x = pkh(s[0 * 33], s[1 * 33]); o.y = pkh(s[2 * 33], s[3 * 33]); o.z = pkh(s[4 * 33], s[5 * 33]); o.w = pkh(s[6 * 33], s[7 * 33]);
        if (n0 + n < N) *(u32x4*)(WT + (size_t)(winperm == 1 ? win_prow(n0 + n) : winperm == 2 ? up_prow(n0 + n) : (n0 + n)) * K + k0 + 8 * c) = o; }
    asm volatile("s_waitcnt lgkmcnt(0)" ::: "memory");
}

__device__ __forceinline__ void p0_prologue(const Params& p, LAS unsigned char* lds, int gw, int NGW, int wave, int lane) {
    unsigned char* ws = p.ws;
    LAS float* scr = (LAS float*)(lds + wave * 16384);
    constexpr int I_IN = (DM / 64) * ((NPROJ + 31) / 32), I_GLU = (DSSM / 64) * (DSSM / 32), I_OUT = (DM / 64) * (DM / 32), I_UP = (DM / 64) * (DUP / 32), I_DN = (DFF / 64) * (DM / 32);
    constexpr int NITEMS = I_IN + I_GLU + I_OUT + I_UP + I_DN;
    for (int it = gw; it < NITEMS; it += NGW) {
        int r = it;
        if (r < I_IN) { transpose_item(p.w_in, DM, NPROJ, (h16*)(ws + WS_WIN), scr, r, lane, nullptr, nullptr, 1); continue; } r -= I_IN;
        if (r < I_GLU) { transpose_item(p.w_glu, DSSM, DSSM, (h16*)(ws + WS_WGLU), scr, r, lane); continue; } r -= I_GLU;
        if (r < I_OUT) { transpose_item(p.w_out, DM, DM, (h16*)(ws + WS_WOUT), scr, r, lane, p.on_ssm, p.on_attn); continue; } r -= I_OUT;
        if (r < I_UP) { transpose_item(p.w_up, DM, DUP, (h16*)(ws + WS_WUP), scr, r, lane, nullptr, nullptr, 2); continue; } r -= I_UP;
        transpose_item(p.w_down, DFF, DM, (h16*)(ws + WS_WDOWN), scr, r, lane);
    }
    { const int nA = (2688 - 2600) * DM * 2 / 16, nB = (2816 - 2720) * DM * 2 / 16;
      u32x4* padA = (u32x4*)((h16*)(ws + WS_WIN) + (size_t)2600 * DM); u32x4* padB = (u32x4*)((h16*)(ws + WS_WIN) + (size_t)2720 * DM);
      for (int i = gw * 64 + lane; i < nA + nB; i += NGW * 64) { if (i < nA) padA[i] = (u32x4){0u, 0u, 0u, 0u}; else padB[i - nA] = (u32x4){0u, 0u, 0u, 0u}; } }
    float* MOD = (float*)(ws + WS_CTL + CTL_MOD_OFF);
    {
        LAS float* part = (LAS float*)(lds + 131072);
        LAS f32x4* sl = (LAS f32x4*)lds;
        if ((int)blockIdx.x < NMOD / 32) {
            __syncthreads();
            for (int k = (int)threadIdx.x; k < DM; k += NT) { const float c0 = p.c[k], c1 = p.c[DM + k], c2 = p.c[2 * DM + k], c3 = p.c[3 * DM + k];
                sl[k] = (f32x4){c0 * sigmoidf_(c0), c1 * sigmoidf_(c1), c2 * sigmoidf_(c2), c3 * sigmoidf_(c3)}; }
            __syncthreads();
        }
        for (int cgp = (int)blockIdx.x; cgp < NMOD / 32; cgp += (int)gridDim.x) {
            const int col = lane & 31, ks = lane >> 5, j = cgp * 32 + col, k0 = wave * 128;
            float a0 = 0.f, a1 = 0.f, a2 = 0.f, a3 = 0.f;
            float wv_[64];
#pragma unroll
            for (int i = 0; i < 64; ++i) wv_[i] = __builtin_nontemporal_load(p.w_ada + (size_t)(k0 + 2 * i + ks) * NMOD + j);
#pragma unroll
            for (int i = 0; i < 64; ++i) { const f32x4 sv = sl[k0 + 2 * i + ks]; const float w = wv_[i];
                a0 += sv[0] * w; a1 += sv[1] * w; a2 += sv[2] * w; a3 += sv[3] * w; }
            a0 += __shfl_xor(a0, 32); a1 += __shfl_xor(a1, 32); a2 += __shfl_xor(a2, 32); a3 += __shfl_xor(a3, 32);
            if (ks == 0) { part[(wave * 4 + 0) * 32 + col] = a0; part[(wave * 4 + 1) * 32 + col] = a1; part[(wave * 4 + 2) * 32 + col] = a2; part[(wave * 4 + 3) * 32 + col] = a3; }
            __syncthreads();
            if (threadIdx.x < 128) { const int bq = threadIdx.x >> 5, cq = threadIdx.x & 31; float sum = p.b_ada[cgp * 32 + cq];
#pragma unroll
                for (int wv = 0; wv < 8; ++wv) sum += part[(wv * 4 + bq) * 32 + cq];
                MOD[(size_t)bq * NMOD + cgp * 32 + cq] = sum; }
            __syncthreads();
        }
    }
    float* RC = (float*)(ws + WS_ROPE); float* RS = RC + (size_t)M * 32;
    for (int i = gw * 64 + lane; i < M * 32; i += NGW * 64) { const int tok = i >> 5, f = i & 31;
        const float inv = exp2f(-(float)f * (13.287712379549449f / 32.0f));
        const float ang = (float)p.positions[tok] * inv;
        RC[i] = cosf(ang); RS[i] = sinf(ang); }
}

__device__ __forceinline__ void norm_mod_rows(const float* X, const float* gwt, const float* MOD, int sh_off, int sc_off, h16* OUT, int gw, int NGW, int lane) {
    int m = gw; f32x4 v[4], v1[4];
    if (m < M) { const f32x4* xr = (const f32x4*)(X + (size_t)m * DM) + lane;
#pragma unroll
        for (int j = 0; j < 4; ++j) v[j] = __builtin_nontemporal_load(xr + 64 * j); }
    if (m + NGW < M) { const f32x4* xr = (const f32x4*)(X + (size_t)(m + NGW) * DM) + lane;
#pragma unroll
        for (int j = 0; j < 4; ++j) v1[j] = __builtin_nontemporal_load(xr + 64 * j); }
    for (; m < M; m += NGW) {
        const int mn = m + 2 * NGW; f32x4 vn[4];
        if (mn < M) { const f32x4* xr = (const f32x4*)(X + (size_t)mn * DM) + lane;
#pragma unroll
            for (int j = 0; j < 4; ++j) vn[j] = __builtin_nontemporal_load(xr + 64 * j); }
        const int b = m / SL;
        const float* shp = MOD + (size_t)b * NMOD + sh_off; const float* scp = MOD + (size_t)b * NMOD + sc_off;
        f32x4 g[4], sh[4], sc[4];
#pragma unroll
        for (int j = 0; j < 4; ++j) { const int col = 4 * lane + 256 * j; g[j] = *(const f32x4*)(gwt + col); sh[j] = *(const f32x4*)(shp + col); sc[j] = *(const f32x4*)(scp + col); }
        float s = 0.f;
#pragma unroll
        for (int j = 0; j < 4; ++j) s += (v[j][0] * v[j][0] + v[j][1] * v[j][1]) + (v[j][2] * v[j][2] + v[j][3] * v[j][3]);
        const float rstd = frsq(wave_sum(s) * (1.0f / DM) + EPS);
#pragma unroll
        for (int j = 0; j < 4; ++j) { const int col = 4 * lane + 256 * j;
            const f32x4 o = v[j] * rstd * g[j] * (sc[j] + 1.0f) + sh[j];
            u32x2_t w; w.x = pkh(o[0], o[1]); w.y = pkh(o[2], o[3]);
            *(u32x2_t*)(OUT + (size_t)m * DM + col) = w; }
#pragma unroll
        for (int j = 0; j < 4; ++j) { v[j] = v1[j]; v1[j] = vn[j]; }
    }
}

__device__ __forceinline__ void bias2_rows(const Params& p, const float* MOD, int gw, int NGW, int lane) {
    const h16* WT = (const h16*)(p.ws + WS_WUP); float* B2 = (float*)(p.ws + WS_BIAS2);
    float sh[4][16];
#pragma unroll
    for (int b = 0; b < 4; ++b)
#pragma unroll
        for (int i = 0; i < 4; ++i) { const f32x4 v = *(const f32x4*)(MOD + (size_t)b * NMOD + 3 * DM + 16 * lane + 4 * i); sh[b][4 * i] = v[0]; sh[b][4 * i + 1] = v[1]; sh[b][4 * i + 2] = v[2]; sh[b][4 * i + 3] = v[3]; }
    for (int n = gw; n < DUP; n += NGW) {
        const h16x8 w0 = *(const h16x8*)(WT + (size_t)n * DM + 16 * lane), w1 = *(const h16x8*)(WT + (size_t)n * DM + 16 * lane + 8);
        float a[4] = {0.f, 0.f, 0.f, 0.f};
#pragma unroll
        for (int b = 0; b < 4; ++b) {
#pragma unroll
            for (int i = 0; i < 8; ++i) a[b] += sh[b][i] * (float)w0[i] + sh[b][8 + i] * (float)w1[i]; }
#pragma unroll
        for (int b = 0; b < 4; ++b) { const float t = wave_sum(a[b]); if (lane == 0) B2[(size_t)b * DUP + n] = t; }
    }
}

__device__ __forceinline__ void rope_norm8(h16* ptr, bool do_norm, const float* gw_, float scale, const f32x4 cs, const f32x4 sn) {
    const h16x4 lo = *(const h16x4*)ptr, hi = *(const h16x4*)(ptr + 32);
    float x1[4], x2[4]; float ss = 0.f;
#pragma unroll
    for (int i = 0; i < 4; ++i) { x1[i] = (float)lo[i]; x2[i] = (float)hi[i]; ss += x1[i] * x1[i] + x2[i] * x2[i]; }
    if (do_norm) {
        ss += __shfl_xor(ss, 1); ss += __shfl_xor(ss, 2); ss += __shfl_xor(ss, 4);
        const float rstd = 1.0f / sqrtf(ss * (1.0f / 64.0f) + EPS);
#pragma unroll
        for (int i = 0; i < 4; ++i) { x1[i] *= rstd * gw_[i]; x2[i] *= rstd * gw_[32 + i]; }
    }
    float y1[4], y2[4];
#pragma unroll
    for (int i = 0; i < 4; ++i) { y1[i] = (x1[i] * cs[i] - x2[i] * sn[i]) * scale; y2[i] = (x1[i] * sn[i] + x2[i] * cs[i]) * scale; }
    u32x2_t a, b; a.x = pkh(y1[0], y1[1]); a.y = pkh(y1[2], y1[3]); b.x = pkh(y2[0], y2[1]); b.y = pkh(y2[2], y2[3]);
    *(u32x2_t*)ptr = a; *(u32x2_t*)(ptr + 32) = b;
}
__device__ __forceinline__ void p3_token_pass(const Params& p, int gw, int NGW, int lane) {
    unsigned char* ws = p.ws;
    h16* Q = (h16*)(ws + WS_Q); h16* K = (h16*)(ws + WS_K); h16* V = (h16*)(ws + WS_V); h16* QI = (h16*)(ws + WS_QI); h16* KI = (h16*)(ws + WS_KI); h16* VT = (h16*)(ws + WS_VT);
    const float* RC = (const float*)(ws + WS_ROPE); const float* RS = RC + (size_t)M * 32;
    const int hh = lane >> 3, e = lane & 7;
    for (int tok = gw; tok < M; tok += NGW) {
        const f32x4 cs = *(const f32x4*)(RC + (size_t)tok * 32 + 4 * e), sn = *(const f32x4*)(RS + (size_t)tok * 32 + 4 * e);
        const size_t o = (size_t)tok * 512 + hh * 64 + 4 * e;
        rope_norm8(Q + o, true, p.q_norm + 4 * e, QSCALE, cs, sn);
        rope_norm8(K + o, true, p.k_norm + 4 * e, 1.0f, cs, sn);
        rope_norm8(QI + o, false, nullptr, 1.0f, cs, sn);
        if (hh == 0) {
            h16* kr = KI + (size_t)tok * 64 + 4 * e; rope_norm8(kr, false, nullptr, 1.0f, cs, sn);
            const int bb = tok / SL, key = tok % SL; h16* kf = (h16*)(ws + WS_KIF) + ((size_t)(bb * (SL / 32) + (key >> 5)) * 8) * 256 + (key & 31) * 8;
            const int sh0 = ((e >> 2) * 2 + ((e >> 1) & 1)) * 256 + 4 * (e & 1);
            *(u32x2_t*)(kf + sh0) = *(const u32x2_t*)kr; *(u32x2_t*)(kf + sh0 + 4 * 256) = *(const u32x2_t*)(kr + 32); }
    }
}


__device__ __forceinline__ f32x2 cmul(f32x2 a, f32x2 b) { return (f32x2){a.x * b.x - a.y * b.y, a.x * b.y + a.y * b.x}; }
__device__ __forceinline__ void s5_tables(const Params& p, int item, LAS unsigned char* lds) {
    const int tid = threadIdx.x, g = item >> 3, part = item & 7;
    LAS f32x2* pw = (LAS f32x2*)lds;
    LAS f32x2* bb = pw + 33 * 64;
    LAS f32x2* cc = bb + 64 * 16;
    h16* WST = (h16*)(p.ws + WS_WST) + (size_t)g * 128 * 512; h16* WOT = (h16*)(p.ws + WS_WOT) + (size_t)g * 512 * 128; h16* KT = (h16*)(p.ws + WS_KT) + (size_t)g * 32 * 256;
    float* L32 = (float*)(p.ws + WS_L32); float* DTT = L32 + 32 * 64 * 2;
    __syncthreads();
    if (tid < 64) {
        const int pp = tid; const float dt = expf(p.log_dt[g]);
        const float lr = p.a_re[g * 64 + pp], li = p.a_im[g * 64 + pp];
        const float mag = expf(lr * dt), ang = li * dt; const f32x2 lb = {mag * cosf(ang), mag * sinf(ang)};
        const float den = lr * lr + li * li, nr = lb.x - 1.0f, ni = lb.y;
        const float cr = (nr * lr + ni * li) / den / dt, ci = (ni * lr - nr * li) / den / dt;
        f32x2 z = {1.0f, 0.0f}; pw[pp] = z;
#pragma unroll 1
        for (int d = 1; d <= 32; ++d) { z = cmul(z, lb); pw[d * 64 + pp] = z; }
#pragma unroll
        for (int c = 0; c < 16; ++c) { const float br = p.b_re[(size_t)(g * 64 + pp) * 16 + c], bi = p.b_im[(size_t)(g * 64 + pp) * 16 + c];
            bb[pp * 16 + c] = (f32x2){cr * br - ci * bi, cr * bi + ci * br}; }
        if (part == 0) { L32[(g * 64 + pp) * 2] = z.x; L32[(g * 64 + pp) * 2 + 1] = z.y; if (pp == 0) DTT[g] = dt; }
    }
    for (int i = tid; i < 1024; i += NT) cc[i] = (f32x2){p.c_re[(size_t)g * 1024 + i], p.c_im[(size_t)g * 1024 + i]};
    __syncthreads();
    {
        const int idx = part * 512 + tid, col = idx >> 5, s_ = idx & 31, ri = (col >> 4) & 1, pq = 16 * (col >> 5) + (col & 15);
        const f32x2 z = pw[(31 - s_) * 64 + pq]; float v[16];
#pragma unroll
        for (int c = 0; c < 16; ++c) { const f32x2 w = cmul(z, bb[pq * 16 + c]); v[c] = ri ? w.y : w.x; }
        u32x4 o0, o1; o0.x = pkh(v[0], v[1]); o0.y = pkh(v[2], v[3]); o0.z = pkh(v[4], v[5]); o0.w = pkh(v[6], v[7]);
        o1.x = pkh(v[8], v[9]); o1.y = pkh(v[10], v[11]); o1.z = pkh(v[12], v[13]); o1.w = pkh(v[14], v[15]);
        h16* dst = WST + (size_t)col * 512 + 16 * s_; *(u32x4*)dst = o0; *(u32x4*)(dst + 8) = o1;
    }
#pragma unroll
    for (int i = 0; i < 2; ++i) {
        const int it = part * 1024 + tid + 512 * i, row = it >> 4, kc = it & 15, tau = row >> 4, c = row & 15, k0 = 8 * kc, ri = (k0 >> 4) & 1, pbase = 16 * (k0 >> 5) + (k0 & 15);
        float v[8];
#pragma unroll
        for (int j = 0; j < 8; ++j) { const f32x2 gq = cmul(cc[c * 64 + pbase + j], pw[(tau + 1) * 64 + pbase + j]); v[j] = ri ? -gq.y : gq.x; }
        u32x4 o; o.x = pkh(v[0], v[1]); o.y = pkh(v[2], v[3]); o.z = pkh(v[4], v[5]); o.w = pkh(v[6], v[7]);
        *(u32x4*)(WOT + (size_t)row * 128 + k0) = o;
    }
#pragma unroll
    for (int i = 0; i < 2; ++i) {
        const int e = part * 1024 + tid + 512 * i, d = e >> 8, c = (e >> 4) & 15, c2 = e & 15; float acc = 0.f;
#pragma unroll 4
        for (int q = 0; q < 64; ++q) { const f32x2 t1 = cmul(cc[c * 64 + q], pw[d * 64 + q]); const f32x2 b2 = bb[q * 16 + c2]; acc += t1.x * b2.x - t1.y * b2.y; }
        KT[e] = (h16)acc;
    }
    __syncthreads();
}

__device__ __forceinline__ void s5_unit_mfma(const Params& p, int bg, LAS unsigned char* lds) {
    int tid = threadIdx.x; asm volatile("" : "+v"(tid));
    const int lane = tid & 63, wave = __builtin_amdgcn_readfirstlane(tid >> 6), r = lane & 31, hi = lane >> 5, b = bg >> 5, g = bg & 31;
    constexpr int U_OFF = 0, KT_OFF = 33280, S_OFF = 49664, X_OFF = 82432, XPITCH = 136;
    LAS unsigned char* U_s = lds + U_OFF; LAS h16* KT_s = (LAS h16*)(lds + KT_OFF); LAS float* S_s = (LAS float*)(lds + S_OFF); LAS h16* X_s = (LAS h16*)(lds + X_OFF);
    const h16* U = (const h16*)(p.ws + WS_U); h16* YS = (h16*)(p.ws + WS_YS);
    const h16* WST = (const h16*)(p.ws + WS_WST) + (size_t)g * 128 * 512; const h16* WOT = (const h16*)(p.ws + WS_WOT) + (size_t)g * 512 * 128; const h16* KT = (const h16*)(p.ws + WS_KT) + (size_t)g * 32 * 256;
    const float* L32 = (const float*)(p.ws + WS_L32); const float dt = L32[32 * 64 * 2 + g];
    lds_barrier();
    const int qA = wave & 3, khA = wave >> 2;
    for (int i = tid; i < 1024; i += NT) *(LAS u32x4*)(KT_s + 8 * i) = *(const u32x4*)(KT + 8 * i);
    const float dsk = p.ssm_d[g * 16 + (r & 15)];
    float l32r = 0.f, l32i = 0.f, xr = 0.f, xi = 0.f;
    if (tid < 64) { l32r = L32[(g * 64 + tid) * 2]; l32i = L32[(g * 64 + tid) * 2 + 1]; }
    const int ufrag_off = r * 1040 + 16 * hi;
    u32x4 un[4];
#pragma unroll
    for (int k = 0; k < 4; ++k) { const int i = tid + 512 * k, t = i >> 1, hf = i & 1; un[k] = __builtin_nontemporal_load((const u32x4*)(U + (size_t)(b * SL + t) * 512 + 16 * g + 8 * hf)); }
    for (int cb = 0; cb < 4; ++cb) {
        h16x8 wst[16];
#pragma unroll
        for (int i = 0; i < 16; ++i) wst[i] = *(const h16x8*)(WST + (size_t)(32 * qA + r) * 512 + 16 * (16 * khA + i) + 8 * hi);
        lds_barrier();
#pragma unroll
        for (int k = 0; k < 4; ++k) { const int i = tid + 512 * k, t = i >> 1, hf = i & 1; *(LAS u32x4*)(U_s + t * 32 + (t >> 5) * 16 + 16 * hf) = un[k]; }
        lds_barrier();
        if (cb < 3) {
#pragma unroll
            for (int k = 0; k < 4; ++k) { const int i = tid + 512 * k, t = i >> 1, hf = i & 1; un[k] = __builtin_nontemporal_load((const u32x4*)(U + (size_t)(b * SL + 1024 * (cb + 1) + t) * 512 + 16 * g + 8 * hf)); }
        }
        {
            f32x16 acc = {};
#pragma unroll
            for (int i = 0; i < 16; ++i) { const h16x8 a = *(const LAS h16x8*)(U_s + ufrag_off + (16 * khA + i) * 32);
                acc = __builtin_amdgcn_mfma_f32_32x32x16_f16(a, wst[i], acc, 0, 0, 0); }
#pragma unroll
            for (int rg = 0; rg < 16; ++rg) S_s[(khA * 32 + crow(rg, hi)) * 128 + 32 * qA + r] = acc[rg];
        }
        h16x8 wot[8];
#pragma unroll
        for (int ks = 0; ks < 8; ++ks) wot[ks] = *(const h16x8*)(WOT + (size_t)(32 * wave + r) * 128 + 16 * ks + 8 * hi);
        lds_barrier();
        if (tid < 64) {
            const int sre = 32 * (tid >> 4) + (tid & 15), sim = sre + 16;
#pragma unroll 4
            for (int ch = 0; ch < 32; ++ch) {
                const float sr = S_s[ch * 128 + sre] + S_s[(32 + ch) * 128 + sre], si = S_s[ch * 128 + sim] + S_s[(32 + ch) * 128 + sim];
                X_s[ch * XPITCH + sre] = (h16)xr; X_s[ch * XPITCH + sim] = (h16)xi;
                const float nxr = l32r * xr - l32i * xi + sr, nxi = l32r * xi + l32i * xr + si; xr = nxr; xi = nxi;
            }
        }
        lds_barrier();
#pragma unroll
        for (int nbi = 0; nbi < 2; ++nbi) {
            const int n = nbi ? 15 - wave : wave, tau = 2 * n + (r >> 4), c = r & 15;
            f32x16 acc = {};
#pragma unroll 2
            for (int s_ = 0; s_ <= 2 * n + 1; ++s_) {
                const h16x8 a = *(const LAS h16x8*)(U_s + ufrag_off + s_ * 32);
                const int d = tau - s_; const int dd = d < 0 ? 0 : d;
                h16x8 bq = *(const LAS h16x8*)(KT_s + (dd * 16 + c) * 16 + 8 * hi);
                if (d < 0) bq = (h16x8){};
                acc = __builtin_amdgcn_mfma_f32_32x32x16_f16(a, bq, acc, 0, 0, 0);
            }
#pragma unroll
            for (int ks = 0; ks < 8; ++ks) { const h16x8 a = *(const LAS h16x8*)(X_s + r * XPITCH + 16 * ks + 8 * hi);
                acc = __builtin_amdgcn_mfma_f32_32x32x16_f16(a, wot[ks], acc, 0, 0, 0); }
            if (nbi == 0) {
#pragma unroll
                for (int ks = 0; ks < 8; ++ks) wot[ks] = *(const h16x8*)(WOT + (size_t)(32 * (15 - wave) + r) * 128 + 16 * ks + 8 * hi);
            }
#pragma unroll
            for (int rg = 0; rg < 16; ++rg) { const int ch = crow(rg, hi), t = 32 * ch + tau;
                const float uval = (float)*(const LAS h16*)(U_s + t * 32 + ch * 16 + 2 * c);
                const float y = dt * acc[rg] + dsk * uval;
                YS[(size_t)(b * SL + 1024 * cb + t) * 512 + 16 * g + c] = (h16)gelu_tanh(y); }
        }
    }
    lds_barrier();
}

__device__ __forceinline__ void s5_unit(const Params& p, int bg, LAS unsigned char* lds) {
    const int tid = threadIdx.x, b = bg >> 5, g = bg & 31;
    LAS float* u_s = (LAS float*)lds;
    LAS f32x2* x_s = (LAS f32x2*)(lds + 4096);
    const h16* U = (const h16*)(p.ws + WS_U); h16* YS = (h16*)(p.ws + WS_YS);
    const int pp = tid & 63, tq = tid >> 6;
    const float dt = expf(p.log_dt[g]);
    const float lr = p.a_re[g * 64 + pp], li = p.a_im[g * 64 + pp];
    const float mag = expf(lr * dt), ang = li * dt;
    const float lb_re = mag * cosf(ang), lb_im = mag * sinf(ang);
    const float den = lr * lr + li * li, nr = lb_re - 1.0f, ni = lb_im;
    const float coef_re = (nr * lr + ni * li) / den, coef_im = (ni * lr - nr * li) / den;
    float bbr[16], bbi[16];
#pragma unroll
    for (int c = 0; c < 16; ++c) { const float br = p.b_re[(size_t)(g * 64 + pp) * 16 + c], bi = p.b_im[(size_t)(g * 64 + pp) * 16 + c];
        bbr[c] = coef_re * br - coef_im * bi; bbi[c] = coef_re * bi + coef_im * br; }
    const int oc = tid & 15, ph = (tid >> 4) & 1, tt = tid >> 5;
    float cre[32], cim[32];
#pragma unroll
    for (int j = 0; j < 32; ++j) { cre[j] = p.c_re[(size_t)(g * 16 + oc) * 64 + ph * 32 + j]; cim[j] = p.c_im[(size_t)(g * 16 + oc) * 64 + ph * 32 + j]; }
    const float dsk = p.ssm_d[g * 16 + oc];
    float xr = 0.f, xi = 0.f;
    for (int chunk = 0; chunk < SL / 64; ++chunk) {
        const size_t row0 = (size_t)b * SL + chunk * 64;
        __syncthreads();
        { const int idx = tid * 2, t = idx >> 4, c = idx & 15; const h16x2 uv = *(const h16x2*)(U + (row0 + t) * 512 + g * 16 + c); u_s[idx] = (float)uv[0]; u_s[idx + 1] = (float)uv[1]; }
        __syncthreads();
#pragma unroll
        for (int i = 0; i < 8; ++i) { const int t = tq + 8 * i; float re = 0.f, im = 0.f;
#pragma unroll
            for (int c4 = 0; c4 < 4; ++c4) { const f32x4 uu = *(const LAS f32x4*)(u_s + t * 16 + 4 * c4);
#pragma unroll
                for (int e = 0; e < 4; ++e) { re += bbr[4 * c4 + e] * uu[e]; im += bbi[4 * c4 + e] * uu[e]; } }
            x_s[t * 64 + pp] = (f32x2){re, im}; }
        __syncthreads();
        if (tid < 64) {
#pragma unroll 8
            for (int t = 0; t < 64; ++t) { const f32x2 v = x_s[t * 64 + pp];
                const float nxr = lb_re * xr - lb_im * xi + v.x, nxi = lb_re * xi + lb_im * xr + v.y; xr = nxr; xi = nxi; x_s[t * 64 + pp] = (f32x2){xr, xi}; }
        }
        __syncthreads();
#pragma unroll
        for (int i = 0; i < 4; ++i) { const int t = tt + 16 * i; float acc = 0.f;
#pragma unroll
            for (int j = 0; j < 32; j += 2) { const f32x4 xx = *(const LAS f32x4*)(x_s + t * 64 + ph * 32 + j);
                acc += xx[0] * cre[j] - xx[1] * cim[j] + xx[2] * cre[j + 1] - xx[3] * cim[j + 1]; }
            acc += __shfl_xor(acc, 16);
            if (ph == 0) { const float y = acc + dsk * u_s[t * 16 + oc]; YS[(row0 + t) * 512 + g * 16 + oc] = (h16)gelu_tanh(y); } }
    }
    __syncthreads();
}

template <int CTRL> __device__ __forceinline__ int dppi(int v) { return __builtin_amdgcn_update_dpp(0, v, CTRL, 0xF, 0xF, true); }
template <int CTRL> __device__ __forceinline__ float dppf(float v) { return __int_as_float(__builtin_amdgcn_update_dpp(0, __float_as_int(v), CTRL, 0xF, 0xF, true)); }
__device__ __forceinline__ float row16_min(float v) { v = fminf(v, dppf<0xB1>(v)); v = fminf(v, dppf<0x4E>(v)); v = fminf(v, dppf<0x141>(v)); return fminf(v, dppf<0x140>(v)); }
__device__ __forceinline__ float row16_max(float v) { v = fmaxf(v, dppf<0xB1>(v)); v = fmaxf(v, dppf<0x4E>(v)); v = fmaxf(v, dppf<0x141>(v)); return fmaxf(v, dppf<0x140>(v)); }
__device__ __forceinline__ int wave_incl_scan(int v) {
    v += dppi<0x111>(v); v += dppi<0x112>(v); v += dppi<0x114>(v); v += dppi<0x118>(v);
    v += __builtin_amdgcn_update_dpp(0, v, 0x142, 0xA, 0xF, false);
    v += __builtin_amdgcn_update_dpp(0, v, 0x143, 0xC, 0xF, false);
    return v;
}
typedef short s16x2_t __attribute__((ext_vector_type(2)));
typedef float f32x2_t_ __attribute__((ext_vector_type(2)));
__device__ __forceinline__ unsigned pkh2(float a, float b) { const f32x2_t_ f = {a, b}; return __builtin_bit_cast(unsigned, __builtin_convertvector(f, h16x2)); }
__device__ __forceinline__ unsigned relu_pkh(float a, float b) { s16x2_t q = __builtin_bit_cast(s16x2_t, pkh2(a, b)); q = __builtin_elementwise_max(q, (s16x2_t){0, 0}); return __builtin_bit_cast(unsigned, q); }
__device__ __forceinline__ unsigned okey2(unsigned p) { s16x2_t sg = __builtin_bit_cast(s16x2_t, p); sg = sg >> (s16x2_t){15, 15}; return p ^ (__builtin_bit_cast(unsigned, sg) | 0x80008000u); }
__device__ __forceinline__ unsigned pk_subsat_u16(unsigned a, unsigned b) { unsigned r_; asm("v_pk_sub_u16 %0, %1, %2 clamp" : "=v"(r_) : "v"(a), "v"(b)); return r_; }
__device__ __forceinline__ unsigned pk_min_u16(unsigned a, unsigned b) { unsigned r_; asm("v_pk_min_u16 %0, %1, %2" : "=v"(r_) : "v"(a), "v"(b)); return r_; }
__device__ __forceinline__ unsigned okey(float f) { const unsigned u = __float_as_uint(f); return (u & 0x80000000u) ? ~u : (u | 0x80000000u); }
__device__ __forceinline__ int hist_pick(const LAS unsigned* hist, int lane, int& need, int& cnt) {
    const int base = 4 * (63 - lane);
    const pg8::u32x4 hv = *(const LAS pg8::u32x4*)(hist + base);
    const int cl = (int)(hv.x + hv.y + hv.z + hv.w);
    const int P = wave_incl_scan(cl);
    const unsigned long long bal = __ballot(P >= need);
    const int Lsel = __builtin_amdgcn_readfirstlane(__ffsll((long long)bal) - 1);
    const int above = __builtin_amdgcn_readlane(P - cl, Lsel);
    const int g3 = __builtin_amdgcn_readlane((int)hv.w, Lsel), g2 = __builtin_amdgcn_readlane((int)hv.z, Lsel), g1 = __builtin_amdgcn_readlane((int)hv.y, Lsel), g0 = __builtin_amdgcn_readlane((int)hv.x, Lsel);
    int cum = above, digit;
    if (cum + g3 >= need) { digit = 3; cnt = g3; } else { cum += g3;
        if (cum + g2 >= need) { digit = 2; cnt = g2; } else { cum += g2;
            if (cum + g1 >= need) { digit = 1; cnt = g1; } else { cum += g1; digit = 0; cnt = g0; } } }
    need -= cum;
    return 4 * (63 - Lsel) + digit;
}
struct TilePrefetch { h16x8 qa[2][4]; f32x4 wv; int tok0; };
__device__ __forceinline__ int queue_tok0(int it) { const int idx = it - NB * NG, pblk = (SL / 8 - 1) - (idx >> 2), bb = idx & 3; return bb * SL + 8 * pblk; }
__device__ __forceinline__ void select_tile(const Params& p, int tok0, LAS unsigned char* lds, TilePrefetch& pf, int nxt) {
    int tid = threadIdx.x; asm volatile("" : "+v"(tid));
    const int lane = tid & 63, wave = __builtin_amdgcn_readfirstlane(tid >> 6), r = lane & 31, hi = lane >> 5;
    LAS float* sc = (LAS float*)lds;
    LAS unsigned* hist = (LAS unsigned*)(lds + 131072) + wave * 448;
    LAS unsigned* rng = (LAS unsigned*)(lds + 131072 + 8 * 448 * 4);
    const h16* QI = (const h16*)(p.ws + WS_QI); const h16* KIF = (const h16*)(p.ws + WS_KIF); const float* WI = (const float*)(p.ws + WS_WI);
    unsigned char* MTB = (unsigned char*)(p.ws + WS_MASK);
    const int b = tok0 >> 12, t0 = tok0 & (SL - 1), nk = t0 + 8, nsub = (nk > TOPK) ? ((nk + 31) >> 5) : 0;
    if (tid < 8) { rng[2 * tid] = 0xFFFFFFFFu; rng[2 * tid + 1] = 0u; }
    h16x8 (&qa)[2][4] = pf.qa;
    h16x8 wfr[2][2];
    if (nsub > 0) {
        if (pf.tok0 != tok0) {
#pragma unroll
            for (int rb = 0; rb < 2; ++rb) {
                const h16* qp = QI + (size_t)(tok0 + 4 * rb + (r >> 3)) * 512 + (r & 7) * 64 + 8 * hi;
#pragma unroll
                for (int s = 0; s < 4; ++s) qa[rb][s] = *(const h16x8*)(qp + 16 * s);
            }
            pf.wv = (f32x4){0.f, 0.f, 0.f, 0.f};
            if (r < 8) pf.wv = *(const f32x4*)(WI + (size_t)(tok0 + r) * 8 + 4 * hi);
        }
        const f32x4 wv = pf.wv;
#pragma unroll
        for (int rb = 0; rb < 2; ++rb)
#pragma unroll
            for (int s = 0; s < 2; ++s)
#pragma unroll
                for (int j = 0; j < 8; ++j) wfr[rb][s][j] = (r == 4 * rb + 2 * s + (j >> 2)) ? (h16)wv[j & 3] : (h16)0.f;
    }
    lds_barrier();
    float mn[4], mx[4];
#pragma unroll
    for (int i = 0; i < 4; ++i) { mn[i] = INFINITY; mx[i] = -INFINITY; }
    const int nmine = (nsub > wave) ? ((nsub - wave + NWAVES - 1) / NWAVES) : 0;
    const int klast = (nmine > 0) ? (nmine - 1) : 0;
    const h16* kbase = KIF + ((size_t)(b * (SL / 32)) * 8 + hi) * 256 + r * 8;
#define KLOAD(dst, kk) do { const int sub_ = wave + NWAVES * min((kk), klast); const h16* kp_ = kbase + (size_t)sub_ * 2048; \
        _Pragma("unroll") for (int s_ = 0; s_ < 4; ++s_) dst[s_] = *(const h16x8*)(kp_ + 512 * s_); } while (0)
#define QK(accv, kf) do { _Pragma("unroll") for (int rb_ = 0; rb_ < 2; ++rb_) accv[rb_] = (f32x16){}; \
        _Pragma("unroll") for (int s_ = 0; s_ < 4; ++s_) _Pragma("unroll") for (int rb_ = 0; rb_ < 2; ++rb_) accv[rb_] = __builtin_amdgcn_mfma_f32_32x32x16_f16(qa[rb_][s_], kf[s_], accv[rb_], 0, 0, 0); } while (0)
#define FINISH(accv, kk) do { f32x16 Y_ = {}; \
        _Pragma("unroll") for (int s_ = 0; s_ < 2; ++s_) _Pragma("unroll") for (int rb_ = 0; rb_ < 2; ++rb_) { pg8::u32x4 x_; \
            x_.x = relu_pkh(accv[rb_][8 * s_], accv[rb_][8 * s_ + 1]); x_.y = relu_pkh(accv[rb_][8 * s_ + 2], accv[rb_][8 * s_ + 3]); x_.z = relu_pkh(accv[rb_][8 * s_ + 4], accv[rb_][8 * s_ + 5]); x_.w = relu_pkh(accv[rb_][8 * s_ + 6], accv[rb_][8 * s_ + 7]); \
            Y_ = __builtin_amdgcn_mfma_f32_32x32x16_f16(wfr[rb_][s_], __builtin_bit_cast(h16x8, x_), Y_, 0, 0, 0); } \
        const int key0_ = 32 * (wave + NWAVES * min((kk), klast)); \
        _Pragma("unroll") for (int q_ = 0; q_ < 4; ++q_) { const float v_ = Y_[q_] + 0.0f; \
            sc[(4 * hi + q_) * 4096 + key0_ + r] = v_; mn[q_] = fminf(mn[q_], v_); mx[q_] = fmaxf(mx[q_], v_); } } while (0)
    if (nmine > 0) {
        h16x8 kA[4], kB[4]; f32x16 accA[2], accB[2];
        KLOAD(kA, 0); KLOAD(kB, 1);
        QK(accA, kA); KLOAD(kA, 2);
        for (int k = 0; k < nmine; k += 2) {
            QK(accB, kB); KLOAD(kB, k + 3);
            FINISH(accA, k);
            QK(accA, kA); KLOAD(kA, k + 4);
            FINISH(accB, k + 1);
        }
    }
#undef KLOAD
#undef QK
#undef FINISH
    if (nsub > 0) {
#pragma unroll
        for (int i = 0; i < 4; ++i) {
            const float rmn = row16_min(mn[i]), rmx = row16_max(mx[i]);
            if ((lane & 15) == 0 && rmx >= rmn) { const int tl = 4 * hi + i;
                __hip_atomic_fetch_min(&rng[2 * tl], okey(rmn), __ATOMIC_RELAXED, __HIP_MEMORY_SCOPE_WORKGROUP);
                __hip_atomic_fetch_max(&rng[2 * tl + 1], okey(rmx), __ATOMIC_RELAXED, __HIP_MEMORY_SCOPE_WORKGROUP); }
        }
    }
    LAS int* slot2 = (LAS int*)(lds + LDS_BYTES - 56);
    if (tid == 0) *slot2 = nxt;
    lds_barrier();
    {
        const int it2 = *slot2; pf.tok0 = -1;
        if (it2 >= NB * NG && it2 < NB * NG + M / 8) { const int tk = queue_tok0(it2);
            if ((tk & (SL - 1)) + 8 > TOPK) { pf.tok0 = tk;
#pragma unroll
                for (int rb = 0; rb < 2; ++rb) { const h16* qp = QI + (size_t)(tk + 4 * rb + (r >> 3)) * 512 + (r & 7) * 64 + 8 * hi;
#pragma unroll
                    for (int s = 0; s < 4; ++s) pf.qa[rb][s] = *(const h16x8*)(qp + 16 * s); }
                pf.wv = (f32x4){0.f, 0.f, 0.f, 0.f};
                if (r < 8) pf.wv = *(const f32x4*)(WI + (size_t)(tk + r) * 8 + 4 * hi); } }
    }
    {
        const int t = t0 + wave, n = t + 1;
        const LAS float* row = sc + wave * 4096;
        LAS unsigned* mrow = (LAS unsigned*)(sc + wave * 4096);
        if (n <= TOPK) {
#pragma unroll
            for (int k = 0; k < 2; ++k) { const int wq = lane + 64 * k, lo = 32 * wq; unsigned wd = 0u;
                if (t >= lo + 31) wd = 0xFFFFFFFFu; else if (t >= lo) wd = (1u << (t - lo + 1)) - 1u;
                mrow[wq] = wd; }
        } else {
            const int n4 = (n + 255) >> 8, nfull = n >> 8;
            LAS float* cv = (LAS float*)(hist + 320); LAS int* ci = (LAS int*)(hist + 384);
            bool done = false;
            const unsigned kmn = rng[2 * wave], kmx = rng[2 * wave + 1];
            const float vmin = __uint_as_float((kmn & 0x80000000u) ? (kmn & 0x7FFFFFFFu) : ~kmn), vmax = __uint_as_float((kmx & 0x80000000u) ? (kmx & 0x7FFFFFFFu) : ~kmx);
            const float range = vmax - vmin;
            if (range > 0.f && range < 3.0e38f) {
                const float fs = 256.0f / range, fo = -vmin * fs;
                int need = TOPK, cnt = 0;
                for (int i = lane; i < 258; i += 64) hist[i] = 0u;
                asm volatile("s_waitcnt lgkmcnt(0)" ::: "memory");
#pragma unroll 4
                for (int j = 0; j < nfull; ++j) { const f32x4 v = *(const LAS f32x4*)(row + 256 * j + 4 * lane);
#pragma unroll
                    for (int e = 0; e < 4; ++e) { const int q1 = min(255, max(0, (int)fmaf(v[e], fs, fo)));
                        __hip_atomic_fetch_add(&hist[q1], 1u, __ATOMIC_RELAXED, __HIP_MEMORY_SCOPE_WORKGROUP); } }
                if (nfull < n4) { const int base = 256 * nfull + 4 * lane; const f32x4 v = *(const LAS f32x4*)(row + base);
#pragma unroll
                    for (int e = 0; e < 4; ++e) { int q1 = min(255, max(0, (int)fmaf(v[e], fs, fo))); q1 = (base + e < n) ? q1 : 256;
                        __hip_atomic_fetch_add(&hist[q1], 1u, __ATOMIC_RELAXED, __HIP_MEMORY_SCOPE_WORKGROUP); } }
                asm volatile("s_waitcnt lgkmcnt(0)" ::: "memory");
                const int b1 = hist_pick(hist, lane, need, cnt);
                int b2 = -1;
                if (cnt > 64) {
                    for (int i = lane; i < 257; i += 64) hist[i] = 0u;
                    asm volatile("s_waitcnt lgkmcnt(0)" ::: "memory");
                    for (int j = 0; j < n4; ++j) { const int base = 256 * j + 4 * lane; const f32x4 v = *(const LAS f32x4*)(row + base);
#pragma unroll
                        for (int e = 0; e < 4; ++e) { const float f = fmaf(v[e], fs, fo); const int q1 = min(255, max(0, (int)f));
                            if (base + e < n && q1 == b1) { const int q2 = min(255, max(0, (int)((f - (float)q1) * 256.0f)));
                                __hip_atomic_fetch_add(&hist[q2], 1u, __ATOMIC_RELAXED, __HIP_MEMORY_SCOPE_WORKGROUP); } } }
                    asm volatile("s_waitcnt lgkmcnt(0)" ::: "memory");
                    b2 = hist_pick(hist, lane, need, cnt);
                }
                if (cnt <= 64) {
                    asm volatile("s_waitcnt lgkmcnt(0)" ::: "memory");
#pragma unroll 4
                    for (int j = 0; j < 16; ++j) {
                        unsigned wd = 0u;
                        if (j < n4) { const int base = 256 * j + 4 * lane; const f32x4 v = *(const LAS f32x4*)(row + base);
#pragma unroll
                            for (int e = 0; e < 4; ++e) { const float f = fmaf(v[e], fs, fo); const int q1 = min(255, max(0, (int)f));
                                bool sel = q1 > b1, cand = q1 == b1;
                                if (b2 >= 0 && cand) { const int q2 = min(255, max(0, (int)((f - (float)q1) * 256.0f))); sel = q2 > b2; cand = q2 == b2; }
                                if (j >= nfull && base + e >= n) { sel = false; cand = false; }
                                wd |= (sel ? 1u : 0u) << e;
                                if (cand) { const unsigned pos = __hip_atomic_fetch_add(&hist[257], 1u, __ATOMIC_RELAXED, __HIP_MEMORY_SCOPE_WORKGROUP);
                                    if (pos < 64u) { cv[pos] = v[e]; ci[pos] = base + e; } } }
                            wd <<= 4 * (lane & 7);
                            wd |= (unsigned)dppi<0xB1>((int)wd); wd |= (unsigned)dppi<0x4E>((int)wd); wd |= (unsigned)dppi<0x141>((int)wd); }
                        if ((lane & 7) == 0) mrow[8 * j + (lane >> 3)] = wd;
                    }
                    asm volatile("s_waitcnt lgkmcnt(0)" ::: "memory");
                    float myv = 0.f; int myi = 0; int rank = 1 << 30;
                    if (lane < cnt) { myv = cv[lane]; myi = ci[lane]; rank = 0; }
                    for (int k = 0; k < cnt; ++k) { const float vk = cv[k]; const int ik = ci[k]; if (lane < cnt && (vk > myv || (vk == myv && ik < myi))) ++rank; }
                    if (rank < need) __hip_atomic_fetch_or(&mrow[myi >> 5], 1u << (myi & 31), __ATOMIC_RELAXED, __HIP_MEMORY_SCOPE_WORKGROUP);
                    done = true;
                }
            }
            if (!done) {
                float thr_v = 0.f; int thr_i = -1; bool have = false;
                unsigned prefix = 0u; int need = TOPK, cnt = 0;
                for (int pass = 0; pass < 4; ++pass) {
                    const int shift = 24 - 8 * pass;
                    for (int i = lane; i < 256; i += 64) hist[i] = 0u;
                    asm volatile("s_waitcnt lgkmcnt(0)" ::: "memory");
                    for (int i = lane; i < n; i += 64) { const unsigned uk = okey(row[i]);
                        const bool match = (pass == 0) || ((uk >> (shift + 8)) == prefix);
                        if (match) __hip_atomic_fetch_add(&hist[(uk >> shift) & 255u], 1u, __ATOMIC_RELAXED, __HIP_MEMORY_SCOPE_WORKGROUP); }
                    asm volatile("s_waitcnt lgkmcnt(0)" ::: "memory");
                    prefix = (prefix << 8) | (unsigned)hist_pick(hist, lane, need, cnt);
                }
                int rem = need;
                for (int c = 0; c < ((n + 63) >> 6) && !have; ++c) { const int i = 64 * c + lane; const bool eqb = (i < n) && (okey(row[i]) == prefix);
                    unsigned long long eq = __ballot(eqb); const int pe = __popcll(eq);
                    if (pe >= rem) { for (int k = 1; k < rem; ++k) eq &= eq - 1ull; const int src = __ffsll((long long)eq) - 1;
                        thr_i = 64 * c + src; thr_v = row[thr_i]; have = true; } else rem -= pe; }
                for (int j = 0; j < 16; ++j) {
                    unsigned wd = 0u;
                    if (j < n4) { const int base = 256 * j + 4 * lane; const f32x4 v = *(const LAS f32x4*)(row + base);
#pragma unroll
                        for (int e = 0; e < 4; ++e) { const bool bit = (base + e < n) && ((v[e] > thr_v) || (v[e] == thr_v && base + e <= thr_i)); wd |= (bit ? 1u : 0u) << e; }
                        wd <<= 4 * (lane & 7);
                        wd |= (unsigned)dppi<0xB1>((int)wd); wd |= (unsigned)dppi<0x4E>((int)wd); wd |= (unsigned)dppi<0x141>((int)wd); }
                    if ((lane & 7) == 0) mrow[8 * j + (lane >> 3)] = wd;
                }
            }
        }
    }
    lds_barrier();
    {
        const int wq = tid >> 2, sh = 8 * (tid & 3);
        unsigned long long x = 0ull;
#pragma unroll
        for (int tl = 0; tl < 8; ++tl) { const unsigned wv = ((const LAS unsigned*)(sc + tl * 4096))[wq]; x |= (unsigned long long)((wv >> sh) & 0xFFu) << (8 * tl); }
        unsigned long long t_;
        t_ = (x ^ (x >> 7)) & 0x00AA00AA00AA00AAull; x = x ^ t_ ^ (t_ << 7);
        t_ = (x ^ (x >> 14)) & 0x0000CCCC0000CCCCull; x = x ^ t_ ^ (t_ << 14);
        t_ = (x ^ (x >> 28)) & 0x00000000F0F0F0F0ull; x = x ^ t_ ^ (t_ << 28);
        const int qw = t0 >> 5, q8 = (t0 >> 3) & 3;
        const size_t W = ((((size_t)(b * 128 + qw) * 64 + (tid >> 3)) * 2 + ((tid >> 2) & 1)) * 16 + 4 * (tid & 3));
        unsigned char* dst = MTB + W * 8 + q8;
#pragma unroll
        for (int j = 0; j < 8; ++j) dst[(j & 3) * 8 + (j >> 2) * 4] = (unsigned char)(x >> (8 * j));
    }
    lds_barrier();
}

__device__ __forceinline__ int queue_tok0_16(int it) { const int idx = it - NB * NG, pblk = (SL / 16 - 1) - (idx >> 2), bb = idx & 3; return bb * SL + 16 * pblk; }
struct TilePf16 { h16x8 qa[8][2]; pg8::f32x4 wv; int tok0; };
__device__ __forceinline__ void tile16_fetch(const Params& p, int tok0, int lane, TilePf16& pf) {
    const h16* QI = (const h16*)(p.ws + WS_QI); const float* WI = (const float*)(p.ws + WS_WI); const int q4 = lane >> 4, c16 = lane & 15;
#pragma unroll
    for (int mt = 0; mt < 8; ++mt) { const h16* qp = QI + (size_t)(tok0 + 2 * mt + (c16 >> 3)) * 512 + (c16 & 7) * 64 + 8 * q4;
#pragma unroll
        for (int ks = 0; ks < 2; ++ks) pf.qa[mt][ks] = *(const h16x8*)(qp + 32 * ks); }
    pf.wv = *(const pg8::f32x4*)(WI + (size_t)(tok0 + c16) * 8 + 4 * (q4 & 1));
    pf.tok0 = tok0;
}
__device__ __forceinline__ void select_tile16(const Params& p, int tok0, LAS unsigned char* lds, TilePf16& pf, int nxt) {
    int tid = threadIdx.x; asm volatile("" : "+v"(tid));
    const int lane = tid & 63, wave = __builtin_amdgcn_readfirstlane(tid >> 6);
    constexpr int SCP = 4112;
    constexpr int HWU = 260;
    LAS unsigned short* sc = (LAS unsigned short*)lds;
    LAS unsigned* hst = (LAS unsigned*)(lds + 16 * SCP * 2);
    static_assert(16 * SCP * 2 + 16 * HWU * 4 + 64 <= LDS_BYTES, "LDS");
    const h16* QI = (const h16*)(p.ws + WS_QI); const h16* KIF = (const h16*)(p.ws + WS_KIF); const float* WI = (const float*)(p.ws + WS_WI);
    unsigned char* MTB = (unsigned char*)(p.ws + WS_MASK);
    const int b = tok0 >> 12, t0 = tok0 & (SL - 1), nk = t0 + 16, nsub = (nk > TOPK) ? ((nk + 31) >> 5) : 0;
    for (int i = tid; i < 16 * HWU; i += NT) hst[i] = 0u;
    if (nsub > 0) {
        const int z0 = 32 * nsub, nch = ((((nk + 511) >> 9) << 9) - z0) >> 3;
        LAS unsigned short* zr = sc + (tid >> 5) * SCP + z0;
        for (int c = tid & 31; c < nch; c += 32) *(LAS pg8::u32x4*)(zr + 8 * c) = (pg8::u32x4){0u, 0u, 0u, 0u};
    }
    lds_barrier();
    if (nsub > 0) {
        typedef float f32x4v __attribute__((ext_vector_type(4)));
        const int q4 = lane >> 4, c16 = lane & 15;
        h16x8 wf[4];
        if (pf.tok0 != tok0) tile16_fetch(p, tok0, lane, pf);
        h16x8 (&qa)[8][2] = pf.qa;
        { const pg8::f32x4 wv = pf.wv;
#pragma unroll
          for (int u = 0; u < 4; ++u)
#pragma unroll
            for (int j = 0; j < 8; ++j) wf[u][j] = (((c16 >> 2) == u) && ((c16 & 1) == (q4 >> 1)) && ((j >> 2) == ((c16 & 3) >> 1))) ? (h16)wv[j & 3] : (h16)0.f; }
        const int nmine = (nsub > wave) ? ((nsub - wave + NWAVES - 1) / NWAVES) : 0;
        const h16* kbase = KIF + (size_t)(b * (SL / 16)) * 1024 + lane * 8;
        LAS unsigned short* scl = sc + (4 * q4) * SCP + c16;
        LAS unsigned* hl = hst + (4 * q4) * HWU;
        const int clim = t0 + 4 * q4 - c16;
#define QK16(Cv, kf) do { _Pragma("unroll") for (int mt_ = 0; mt_ < 8; ++mt_) Cv[mt_] = (f32x4v){0.f, 0.f, 0.f, 0.f}; \
        _Pragma("unroll") for (int ks_ = 0; ks_ < 2; ++ks_) _Pragma("unroll") for (int mt_ = 0; mt_ < 8; ++mt_) Cv[mt_] = __builtin_amdgcn_mfma_f32_16x16x32_f16(qa[mt_][ks_], kf[ks_], Cv[mt_], 0, 0, 0); } while (0)
#define FIN16(Cv, sub_, nt_) do { f32x4v Y_ = {0.f, 0.f, 0.f, 0.f}; \
        _Pragma("unroll") for (int u_ = 0; u_ < 4; ++u_) { pg8::u32x4 x_; \
            x_.x = relu_pkh(Cv[2 * u_][0], Cv[2 * u_][1]); x_.y = relu_pkh(Cv[2 * u_][2], Cv[2 * u_][3]); x_.z = relu_pkh(Cv[2 * u_ + 1][0], Cv[2 * u_ + 1][1]); x_.w = relu_pkh(Cv[2 * u_ + 1][2], Cv[2 * u_ + 1][3]); \
            Y_ = __builtin_amdgcn_mfma_f32_16x16x32_f16(wf[u_], __builtin_bit_cast(h16x8, x_), Y_, 0, 0, 0); } \
        const int kb_ = 32 * (sub_) + 16 * (nt_); \
        unsigned k01_ = okey2(pkh2(Y_[0], Y_[1])), k23_ = okey2(pkh2(Y_[2], Y_[3])); \
        if (kb_ + 15 > t0) { const int d_ = kb_ - clim;                                     \
            k01_ = ((d_ <= 0) ? (k01_ & 0xFFFFu) : 0u) | ((d_ <= 1) ? (k01_ & 0xFFFF0000u) : 0u); k23_ = ((d_ <= 2) ? (k23_ & 0xFFFFu) : 0u) | ((d_ <= 3) ? (k23_ & 0xFFFF0000u) : 0u); } \
        LAS unsigned short* sp_ = scl + kb_; \
        sp_[0] = (unsigned short)k01_; sp_[SCP] = (unsigned short)(k01_ >> 16); sp_[2 * SCP] = (unsigned short)k23_; sp_[3 * SCP] = (unsigned short)(k23_ >> 16); \
        __hip_atomic_fetch_add(&hl[(k01_ >> 8) & 0xFFu], 1u, __ATOMIC_RELAXED, __HIP_MEMORY_SCOPE_WORKGROUP); \
        __hip_atomic_fetch_add(&hl[HWU + (k01_ >> 24)], 1u, __ATOMIC_RELAXED, __HIP_MEMORY_SCOPE_WORKGROUP); \
        __hip_atomic_fetch_add(&hl[2 * HWU + ((k23_ >> 8) & 0xFFu)], 1u, __ATOMIC_RELAXED, __HIP_MEMORY_SCOPE_WORKGROUP); \
        __hip_atomic_fetch_add(&hl[3 * HWU + (k23_ >> 24)], 1u, __ATOMIC_RELAXED, __HIP_MEMORY_SCOPE_WORKGROUP); } while (0)
#define KLD16(dst, sub_, nt_) do { _Pragma("unroll") for (int ks_ = 0; ks_ < 2; ++ks_) dst[ks_] = *(const h16x8*)(kbase + (size_t)(2 * (sub_) + (nt_)) * 1024 + 512 * ks_); } while (0)
        if (nmine > 0) {
            const int rot = (int)((blockIdx.x * 11u) % (unsigned)nmine);
            h16x8 k0[2], k1[2], k0n[2]; f32x4v C0[8], C1[8];
            int kr = rot;
            KLD16(k0, wave + NWAVES * kr, 0); KLD16(k1, wave + NWAVES * kr, 1);
            QK16(C0, k0);
            for (int k = 0; k < nmine; ++k) {
                const int sub = wave + NWAVES * kr;
                int krn = kr + 1; if (krn == nmine) krn = 0;
                const int subn = wave + NWAVES * krn;
                KLD16(k0n, subn, 0);
                QK16(C1, k1);
                KLD16(k1, subn, 1);
                FIN16(C0, sub, 0);
                QK16(C0, k0n);
                FIN16(C1, sub, 1);
                kr = krn;
#pragma unroll
                for (int sg_ = 0; sg_ < 40; ++sg_) { __builtin_amdgcn_sched_group_barrier(0x008, 1, 0); __builtin_amdgcn_sched_group_barrier(0x002, 3, 0); }
            }
        }
#undef QK16
#undef FIN16
#undef KLD16
    }
    LAS int* slotn = (LAS int*)(lds + LDS_BYTES - 56);
    if (tid == 0) *slotn = nxt;
    lds_barrier();
    { const int itn = *slotn; pf.tok0 = -1;
      if (itn < NB * NG + M / 16) { const int tokn = queue_tok0_16(itn); if ((tokn & (SL - 1)) + 16 > TOPK) tile16_fetch(p, tokn, lane, pf); } }
    if (nsub == 0) {
#pragma unroll
        for (int rr = 0; rr < 2; ++rr) { const int tl = wave + 8 * rr, t = t0 + tl; LAS unsigned* mrow = (LAS unsigned*)(sc + tl * SCP);
#pragma unroll
            for (int k = 0; k < 2; ++k) { const int wq = lane + 64 * k, lo = 32 * wq;
                unsigned src = 0u; if (t >= lo + 31) src = 0xFFFFFFFFu; else if (t >= lo) src = (1u << (t - lo + 1)) - 1u;
                unsigned o = 0u;
#pragma unroll
                for (int e = 0; e < 8; ++e) o |= ((src >> e) & 0x01010101u) << ((e & 1) * 4 + (e >> 1));
                mrow[wq] = o; } }
    } else {
        const LAS unsigned short* row[2]; LAS unsigned* mrow[2]; LAS unsigned* hw[2]; int n8[2], need[2], cnt[2]; unsigned d1[2], thr2[2]; bool alleq[2]; int eqbase[2];
#pragma unroll
        for (int rr = 0; rr < 2; ++rr) { const int tl = wave + 8 * rr; row[rr] = sc + tl * SCP; mrow[rr] = (LAS unsigned*)(sc + tl * SCP); hw[rr] = hst + tl * HWU;
            n8[rr] = (t0 + tl + 1 + 511) >> 9; need[rr] = TOPK; cnt[rr] = 0; eqbase[rr] = 0; }
#pragma unroll
        for (int rr = 0; rr < 2; ++rr) d1[rr] = (unsigned)hist_pick(hw[rr], lane, need[rr], cnt[rr]);
#pragma unroll
        for (int rr = 0; rr < 2; ++rr) for (int i = lane; i < 256; i += 64) hw[rr][i] = 0u;
        asm volatile("s_waitcnt lgkmcnt(0)" ::: "memory");
#pragma unroll 2
        for (int j = 0; j < n8[1]; ++j) {
#pragma unroll
            for (int rr = 0; rr < 2; ++rr) if (j < n8[rr]) { const unsigned d1x = (d1[rr] << 8) * 0x00010001u;
                const pg8::u32x4 w = *(const LAS pg8::u32x4*)(row[rr] + 512 * j + 8 * lane);
                const unsigned ww[4] = {w.x ^ d1x, w.y ^ d1x, w.z ^ d1x, w.w ^ d1x};
#pragma unroll
                for (int i = 0; i < 4; ++i) { const unsigned lo = ww[i] & 0xFFFFu, hi2 = ww[i] >> 16;
                    if (lo < 256u) __hip_atomic_fetch_add(&hw[rr][lo], 1u, __ATOMIC_RELAXED, __HIP_MEMORY_SCOPE_WORKGROUP);
                    if (hi2 < 256u) __hip_atomic_fetch_add(&hw[rr][hi2], 1u, __ATOMIC_RELAXED, __HIP_MEMORY_SCOPE_WORKGROUP); } } }
        asm volatile("s_waitcnt lgkmcnt(0)" ::: "memory");
#pragma unroll
        for (int rr = 0; rr < 2; ++rr) { const unsigned d2 = (unsigned)hist_pick(hw[rr], lane, need[rr], cnt[rr]);
            thr2[rr] = ((d1[rr] << 8) | d2) * 0x00010001u;
            alleq[rr] = (need[rr] == cnt[rr]); }
        const unsigned one2 = 0x00010001u;
#pragma unroll 2
        for (int j = 0; j < 8; ++j) {
#pragma unroll
            for (int rr = 0; rr < 2; ++rr) {
                unsigned wd = 0u;
                if (j < n8[rr]) { const pg8::u32x4 w = *(const LAS pg8::u32x4*)(row[rr] + 512 * j + 8 * lane);
                    const unsigned ww[4] = {w.x, w.y, w.z, w.w};
                    unsigned G = 0u, NE = 0u;
#pragma unroll
                    for (int i = 0; i < 4; ++i) { G |= pk_min_u16(pk_subsat_u16(ww[i], thr2[rr]), one2) << i; NE |= pk_min_u16(ww[i] ^ thr2[rr], one2) << i; }
                    const unsigned gtm = (G & 0xFu) | ((G >> 12) & 0xF0u), eqm = ~((NE & 0xFu) | ((NE >> 12) & 0xF0u)) & 0xFFu;
                    unsigned take = eqm;
                    if (!alleq[rr]) {
                        const int c = __popc(eqm); const int incl = wave_incl_scan(c); int rank = eqbase[rr] + incl - c; take = 0u;
#pragma unroll
                        for (int e = 0; e < 8; ++e) { const int ps = (e & 1) * 4 + (e >> 1); if ((eqm >> ps) & 1u) { if (rank < need[rr]) take |= 1u << ps; ++rank; } }
                        eqbase[rr] += __builtin_amdgcn_readlane(incl, 63);
                    }
                    wd = (gtm | take) << (8 * (lane & 3));
                    wd |= (unsigned)dppi<0xB1>((int)wd); wd |= (unsigned)dppi<0x4E>((int)wd); }
                if ((lane & 3) == 0) mrow[rr][16 * j + (lane >> 2)] = wd;
            }
        }
    }
    lds_barrier();
    {
        unsigned* MT2 = (unsigned*)MTB;
        const int tl = tid & 15, q = t0 + tl, qblk = q >> 5, ql = q & 31;
        const LAS unsigned* mwr = (const LAS unsigned*)(sc + tl * SCP);
#pragma unroll
        for (int k = 0; k < 2; ++k) { const int kt = (tid >> 4) + 32 * k; const unsigned W0 = mwr[2 * kt], W1 = mwr[2 * kt + 1];
            unsigned* dst = MT2 + (((size_t)(b * 128 + qblk) * 64 + kt) * 64) + ql;
            dst[0] = (W0 & 0x33333333u) | ((W1 & 0x33333333u) << 2);
            dst[32] = ((W0 >> 2) & 0x33333333u) | (((W1 >> 2) & 0x33333333u) << 2); }
    }
    lds_barrier();
}

#define SBAR() __builtin_amdgcn_sched_barrier(0)
namespace attn_body {
using bf16=_Float16;
using bf16x8=__attribute__((ext_vector_type(8)))short;
using s16x4=__attribute__((ext_vector_type(4)))short;
using f32x16=__attribute__((ext_vector_type(16)))float;
using u32x4=__attribute__((ext_vector_type(4)))unsigned;
constexpr int BATCH=4,NHEAD=8,SEQ=4096,D=64,DM=NHEAD*D;
constexpr int NW=8,QBLK=32,QB=QBLK*NW,KVBLK=64,NQB=SEQ/QB;
constexpr int ATTN_PITCH=DM, ATTN_UNIT_ROWS=QB, ODM=1024;
typedef _Float16 hx8 __attribute__((ext_vector_type(8)));
__device__ __forceinline__ f32x16 mfma16(bf16x8 a,bf16x8 b,f32x16 c){return __builtin_amdgcn_mfma_f32_32x32x16_f16(__builtin_bit_cast(hx8,a),__builtin_bit_cast(hx8,b),c,0,0,0);}
typedef const __attribute__((address_space(4))) unsigned long long* cmask_ptr;
__device__ __forceinline__ void tmask(f32x16&p0,f32x16&p1,cmask_ptr m,float mh){
  #pragma unroll
  for(int r=0;r<16;++r){p0[r]=__builtin_amdgcn_inverse_ballot_w64(m[r])?p0[r]:-INFINITY; p1[r]=__builtin_amdgcn_inverse_ballot_w64(m[16+r])?p1[r]:-INFINITY;}
}
__device__ __forceinline__ void tmaskv(f32x16&p0,f32x16&p1,unsigned mw){
  #pragma unroll
  for(int r=0;r<16;++r){ const int b0=8*(r>>2)+((r&1)?4:0)+((r&2)?1:0);
    const int m0=((int)(mw<<(31-b0)))>>31, m1=((int)(mw<<(29-b0)))>>31;
    p0[r]=__uint_as_float(__builtin_amdgcn_bitop3_b32((unsigned)m0,__float_as_uint(p0[r]),0xFF800000u,0xCA)); p1[r]=__uint_as_float(__builtin_amdgcn_bitop3_b32((unsigned)m1,__float_as_uint(p1[r]),0xFF800000u,0xCA)); }
}
__device__ __forceinline__ int crow(int r,int hi){return (r&3)+8*(r>>2)+4*hi;}
#define SBAR() __builtin_amdgcn_sched_barrier(0)
__device__ __forceinline__ void cmask(f32x16&p0,f32x16&p1,int jb,int qrel,int hi){
  const float NEG=-INFINITY; int kb=64*jb+4*hi;
  #pragma unroll
  for(int r=0;r<16;++r){int kv=kb+(r&3)+8*(r>>2); if(kv>qrel)p0[r]=NEG; if(kv+32>qrel)p1[r]=NEG;}
}

constexpr int NSLOT=3, SLOTB=8192;
constexpr int LDS_K=0, LDS_V=NSLOT*SLOTB, LDS_WS=2*NSLOT*SLOTB, LDS_OST=LDS_WS+NW*64*4, LDS_BYTES=LDS_OST+NW*4096;
constexpr float C2=0.125f*1.4426950408889634f;
__device__ __forceinline__ void glds16(const void*gsrc,unsigned lds_dst){unsigned keep;
  asm volatile("s_mov_b32 %0, m0\n\ts_mov_b32 m0, %2\n\ts_nop 0\n\tglobal_load_lds_dwordx4 %1, off\n\ts_mov_b32 m0, %0":"=&s"(keep):"v"(gsrc),"s"(lds_dst):"memory");}
__device__ __forceinline__ float max3f(float a,float b,float c){float r;asm("v_max3_f32 %0, %1, %2, %3":"=v"(r):"v"(a),"v"(b),"v"(c));return r;}
__device__ __forceinline__ float max2f(float a,float b){float r;asm("v_max_f32_e32 %0, %1, %2":"=v"(r):"v"(a),"v"(b));return r;}
__device__ __forceinline__ float fadd_s(float a,float b){float r;asm("v_add_f32_e32 %0, %1, %2":"=v"(r):"v"(a),"v"(b));return r;}
__device__ __forceinline__ float fsub_s(float a,float b){float r;asm("v_sub_f32_e32 %0, %1, %2":"=v"(r):"v"(a),"v"(b));return r;}
typedef float f32x2_t __attribute__((ext_vector_type(2))); typedef _Float16 bf16x2_t __attribute__((ext_vector_type(2)));
__device__ __forceinline__ unsigned cvtpk_s(float lo,float hi){f32x2_t v={lo,hi};bf16x2_t b=__builtin_convertvector(v,bf16x2_t);return __builtin_bit_cast(unsigned,b);}
#define WAIT_BAR(N) asm volatile("s_waitcnt vmcnt(" #N ") lgkmcnt(0)\n\ts_barrier":::"memory")

__device__ __forceinline__ void qkt(f32x16&p0,f32x16&p1,const char*Kslot,const bf16x8*qr,const f32x16&negm,int r32,int hi){
  const char*kb=Kslot+hi*1024+r32*16;
  #pragma unroll
  for(int d0=0;d0<4;++d0){
    const bf16x8 b0=*reinterpret_cast<const bf16x8*>(kb+d0*2048);
    const bf16x8 b1=*reinterpret_cast<const bf16x8*>(kb+d0*2048+512);
    if(d0==0){p0=mfma16(b0,qr[0],negm);p1=mfma16(b1,qr[0],negm);}
    else{p0=mfma16(b0,qr[d0],p0);p1=mfma16(b1,qr[d0],p1);}}
}
typedef __attribute__((address_space(3))) const char* lds_cptr;
typedef short v4i16_t __attribute__((ext_vector_type(4)));
__device__ __forceinline__ void kload8(bf16x8*kf,lds_cptr kp){
  kf[0]=*(const __attribute__((address_space(3))) bf16x8*)(kp);      kf[1]=*(const __attribute__((address_space(3))) bf16x8*)(kp+512);
  kf[2]=*(const __attribute__((address_space(3))) bf16x8*)(kp+2048); kf[3]=*(const __attribute__((address_space(3))) bf16x8*)(kp+2560);
  kf[4]=*(const __attribute__((address_space(3))) bf16x8*)(kp+4096); kf[5]=*(const __attribute__((address_space(3))) bf16x8*)(kp+4608);
  kf[6]=*(const __attribute__((address_space(3))) bf16x8*)(kp+6144); kf[7]=*(const __attribute__((address_space(3))) bf16x8*)(kp+6656);
}
__device__ __forceinline__ void kload2(bf16x8*kf,lds_cptr kp,int j){ kf[2*j]=*(const __attribute__((address_space(3))) bf16x8*)(kp+j*2048); kf[2*j+1]=*(const __attribute__((address_space(3))) bf16x8*)(kp+j*2048+512); }
__device__ __forceinline__ s16x4 vtr(lds_cptr p){ return __builtin_bit_cast(s16x4,__builtin_amdgcn_ds_read_tr16_b64_v4i16((__attribute__((address_space(3))) v4i16_t*)p)); }
__device__ __forceinline__ float rowmax(const f32x16&p0,const f32x16&p1){
  float a=max3f(p0[0],p0[1],p1[0]),b=max3f(p0[2],p0[3],p1[1]);a=max3f(a,p1[2],p1[3]);
  #pragma unroll
  for(int r=4;r<16;r+=4){a=max3f(a,p0[r],p0[r+1]);b=max3f(b,p0[r+2],p0[r+3]);a=max3f(a,p1[r],p1[r+1]);b=max3f(b,p1[r+2],p1[r+3]);}
  const float m=max2f(a,b);
  auto rr=__builtin_amdgcn_permlane32_swap(__float_as_uint(m),__float_as_uint(m),false,false);
  return max2f(__uint_as_float(rr[0]),__uint_as_float(rr[1]));
}
__device__ __forceinline__ void pv(f32x16*o,int vb,bf16x8 pa0,bf16x8 pa1,bf16x8 pa2,bf16x8 pa3){
  #pragma unroll
  for(int d0=0;d0<2;++d0){s16x4 lo[4],hi[4];
    #pragma unroll
    for(int ks=0;ks<4;++ks){
      asm volatile("ds_read_b64_tr_b16 %0,%1 offset:%c2":"=&v"(lo[ks]):"v"(vb),"i"(d0*4096+ks*1024):"memory");
      asm volatile("ds_read_b64_tr_b16 %0,%1 offset:%c2":"=&v"(hi[ks]):"v"(vb),"i"(d0*4096+ks*1024+512):"memory");}
    asm volatile("s_waitcnt lgkmcnt(0)":::"memory");SBAR();
    #define PK(k) (bf16x8){lo[k][0],lo[k][1],lo[k][2],lo[k][3],hi[k][0],hi[k][1],hi[k][2],hi[k][3]}
    o[d0]=mfma16(pa0,PK(0),o[d0]);
    o[d0]=mfma16(pa1,PK(1),o[d0]);
    o[d0]=mfma16(pa2,PK(2),o[d0]);
    o[d0]=mfma16(pa3,PK(3),o[d0]);
    #undef PK
  }
}

#ifndef ATTN_STORE16
#define ATTN_STORE16(p,v) (*(u32x4*)(p)=(v))
#endif
template<int THRL> __device__ __forceinline__ void attn_unit(int b,int h,int qb,const bf16*Q,const bf16*__restrict__ K,const bf16*__restrict__ V,bf16*O,const unsigned long long*MT,float*SSQ,char*shm){
  int tid=threadIdx.x; asm volatile("":"+v"(tid)); const int lane=tid&63,r32=lane&31,hi=lane>>5; const int wid=__builtin_amdgcn_readfirstlane(tid>>6);
  const long rowbase=(long)b*SEQ; const int q0=qb*QB;
  const unsigned*mt2=(const unsigned*)MT+((size_t)(b*(SEQ/32)+qb*NW+wid)*(SEQ/64))*64+lane;
  unsigned mE,mO;
  #define MASKLD(dst,t) asm volatile("global_load_dword %0, %1, off":"=v"(dst):"v"(mt2+(size_t)(t)*64):"memory")
  MASKLD(mE,0); MASKLD(mO,1);
  const bf16*Qw=Q+(rowbase+q0+wid*QBLK)*DM+h*D;
  const bf16*Kh=K+rowbase*DM+h*D,*Vh=V+rowbase*DM+h*D;
  const unsigned lds0=(unsigned)(uintptr_t)shm;
  float*wsf=(float*)(shm+LDS_WS)+wid*64;
  const bf16*ksrc=Kh+(long)lane*DM+wid*8;
  const bf16*vsrc=Vh+(long)(16*(wid&3)+(lane>>2))*DM+(wid>>2)*32+(lane&3)*8;
  const unsigned kdst=lds0+LDS_K+wid*1024, vdst=lds0+LDS_V+wid*1024;
  #define DMA_K(t,slot) glds16(ksrc+(long)(t)*KVBLK*DM,(unsigned)__builtin_amdgcn_readfirstlane(kdst+(slot)))
  #define DMA_V(t,slot) glds16(vsrc+(long)(t)*KVBLK*DM,(unsigned)__builtin_amdgcn_readfirstlane(vdst+(slot)))
  const int vb0=(int)(lds0+LDS_V)+((lane>>4)&1)*32+(lane&3)*8+(4*hi+((lane&15)>>2))*64;
  const char*Kbase=shm+LDS_K; bf16x8 kf[8];
  const lds_cptr shm3=(lds_cptr)shm; const lds_cptr kp0=shm3+LDS_K+hi*1024+r32*16; const lds_cptr vp0=shm3+LDS_V+((lane>>4)&1)*32+(lane&3)*8+(4*hi+((lane&15)>>2))*64;
  const int NT=(q0+QB)/KVBLK;
  DMA_K(0,0);DMA_V(0,0);DMA_K(1,SLOTB);
  bf16x8 qr[4];
  #pragma unroll
  for(int d0=0;d0<4;++d0)qr[d0]=*reinterpret_cast<const bf16x8*>(&Qw[(long)r32*DM+d0*16+hi*8]);
  float mhat=0.f,l_reg=0.f;f32x16 o[2];o[0]=f32x16{};o[1]=f32x16{};f32x16 negm=f32x16{};asm volatile("":"+v"(negm));
  const int qrel=wid*QBLK+r32;
  bool resc=false;
  #define START(P0,P1) do{ const float rm=rowmax(P0,P1); resc=false; \
    { const float dl=__builtin_fmaxf(rm,-64.f); mhat=fadd_s(mhat,dl); \
      _Pragma("unroll") for(int r=0;r<16;++r){P0[r]=fsub_s(P0[r],dl);P1[r]=fsub_s(P1[r],dl);} \
      _Pragma("unroll") for(int r=0;r<16;++r)negm[r]=-mhat; asm volatile("":"+v"(negm)); } \
    _Pragma("unroll") for(int r=0;r<16;++r)P0[r]=__builtin_amdgcn_exp2f(P0[r]); }while(0)
  #define RESC() do{ if(resc){ asm volatile("s_waitcnt lgkmcnt(0)":::"memory"); \
      _Pragma("unroll") for(int d_=0;d_<2;++d_) _Pragma("unroll") for(int r=0;r<16;++r)o[d_][r]*=wsf[crow(r,hi)]; } }while(0)
  f32x16 pA0,pA1,pB0,pB1;
  int sl_prev=0,sl_cur=0,sl_next=SLOTB;
  #define ROT() do{sl_prev=sl_cur;sl_cur=sl_next;sl_next=(sl_next==(NSLOT-1)*SLOTB)?0:sl_next+SLOTB;}while(0)
  DMA_K(2,2*SLOTB);
  WAIT_BAR(3);
  qkt(pA0,pA1,Kbase,qr,negm,r32,hi);asm volatile("s_nop 15\n\ts_nop 7":"+v"(pA0),"+v"(pA1));asm volatile("":"+v"(mE)); tmaskv(pA0,pA1,mE);
  START(pA0,pA1);
  _Pragma("unroll") for(int r=0;r<16;++r)pA1[r]=__builtin_amdgcn_exp2f(pA1[r]);
  WAIT_BAR(0);
  DMA_K(3,0);DMA_V(1,SLOTB);
  ROT();
  kload8(kf,kp0+sl_cur);
  WAIT_BAR(2);
  s16x4 vlo[8],vhi[8]; u32x4 pw0,pw1,pw2,pw3;
  #define PKW(P,B) cvtpk_s(P[B],P[B+1])
  #define PAF(k) __builtin_bit_cast(bf16x8,pw##k)
  #define VFR(i) (bf16x8){vlo[i][0],vlo[i][1],vlo[i][2],vlo[i][3],vhi[i][0],vhi[i][1],vhi[i][2],vhi[i][3]}
  #define PIN(x) asm volatile("":"+v"(x))
  #define MX3(a,b,c) __builtin_fmaxf(__builtin_fmaxf((a),(b)),(c))
  #define GAPA(MF,A0,A1,A2,A3,W0,W1,PW) do{ MF; sacc+=A0; sacc+=A1; sacc+=A2; sacc+=A3; PIN(sacc); W0; W1; PIN(PW); SBAR(); }while(0)
  #define EX(v) __builtin_amdgcn_exp2f(v)
  #define GAPB(MF,X,B) do{ MF; X[B]=EX(X[B]); X[B+1]=EX(X[B+1]); X[B+2]=EX(X[B+2]); X[B+3]=EX(X[B+3]); PIN(X); SBAR(); }while(0)
  #define VRD(i) do{ vlo[i]=vtr(vp_+(((i)>>2)*4096+((i)&3)*1024)); vhi[i]=vtr(vp_+(((i)>>2)*4096+((i)&3)*1024+512)); }while(0)
  #define KRD(G,j) do{ if(G){ kload2(kf,kp0+sl_next,j); SBAR(); } }while(0)
  #define STEP(C0,C1,P0,P1,t,GK,GV,GL,MC,MN) do{ SBAR(); \
    const lds_cptr vp_=vp0+sl_prev; \
    VRD(0); SBAR(); float sacc=(P0[0]+P0[1]); \
    GAPA(C0=mfma16(kf[0],qr[0],negm), P0[2],P0[3],P0[4],P0[5],     pw0[0]=PKW(P0,0), pw0[1]=PKW(P0,2), pw0); \
    VRD(4); SBAR(); GAPA(C1=mfma16(kf[1],qr[0],negm), P0[6],P0[7],P0[8],P0[9],     pw0[2]=PKW(P0,4), pw0[3]=PKW(P0,6), pw0); \
    VRD(1); SBAR(); GAPA(C0=mfma16(kf[2],qr[1],C0),   P0[10],P0[11],P0[12],P0[13], pw1[0]=PKW(P0,8), pw1[1]=PKW(P0,10), pw1); \
    VRD(5); SBAR(); GAPA(C1=mfma16(kf[3],qr[1],C1),   P0[14],P0[15],P1[0],P1[1],   pw1[2]=PKW(P0,12),pw1[3]=PKW(P0,14), pw1); \
    VRD(2); SBAR(); GAPA(C0=mfma16(kf[4],qr[2],C0),   P1[2],P1[3],P1[4],P1[5],     pw2[0]=PKW(P1,0), pw2[1]=PKW(P1,2), pw2); \
    VRD(6); SBAR(); GAPA(C1=mfma16(kf[5],qr[2],C1),   P1[6],P1[7],P1[8],P1[9],     pw2[2]=PKW(P1,4), pw2[3]=PKW(P1,6), pw2); \
    VRD(3); SBAR(); GAPA(C0=mfma16(kf[6],qr[3],C0),   P1[10],P1[11],P1[12],P1[13], pw3[0]=PKW(P1,8), pw3[1]=PKW(P1,10), pw3); \
    VRD(7); SBAR(); GAPA(C1=mfma16(kf[7],qr[3],C1),   P1[14],P1[15],0.f,0.f,       pw3[2]=PKW(P1,12),pw3[3]=PKW(P1,14), pw3); \
    l_reg+=sacc; \
    if((t)+1<NT){MASKLD(MN,(t)+1);} if(GK){DMA_K((t)+3,sl_cur);} if(GV){DMA_V((t)+1,sl_next);} \
    asm volatile("":"+v"(MC)); tmaskv(C0,C1,MC); \
    { float a=MX3(C0[0],C0[1],C1[0]),b=MX3(C0[2],C0[3],C1[1]); a=MX3(a,C1[2],C1[3]); \
      _Pragma("unroll") for(int r=4;r<16;r+=4){a=MX3(a,C0[r],C0[r+1]);b=MX3(b,C0[r+2],C0[r+3]);a=MX3(a,C1[r],C1[r+1]);b=MX3(b,C1[r+2],C1[r+3]);} \
      float rm=__builtin_fmaxf(a,b); { auto rr=__builtin_amdgcn_permlane32_swap(__float_as_uint(rm),__float_as_uint(rm),false,false); rm=__builtin_fmaxf(__uint_as_float(rr[0]),__uint_as_float(rr[1])); } \
      resc=false; \
      if(__builtin_expect(__any(rm>(float)THRL),0)){ const float dl=__builtin_fmaxf(rm,0.f); mhat+=dl; \
        _Pragma("unroll") for(int r=0;r<16;++r){C0[r]-=dl;C1[r]-=dl;} \
        _Pragma("unroll") for(int r=0;r<16;++r)negm[r]=-mhat; asm volatile("":"+v"(negm)); \
        const float f=__builtin_amdgcn_exp2f(-dl); l_reg*=f; if(hi==0)wsf[r32]=f; resc=true; } } \
    SBAR(); \
    GAPB(o[0]=mfma16(PAF(0),VFR(0),o[0]), C0,0); \
    GAPB(o[1]=mfma16(PAF(0),VFR(4),o[1]), C0,4); \
    KRD(GL,0); GAPB(o[0]=mfma16(PAF(1),VFR(1),o[0]), C0,8); \
    KRD(GL,1); GAPB(o[1]=mfma16(PAF(1),VFR(5),o[1]), C0,12); \
    KRD(GL,2); GAPB(o[0]=mfma16(PAF(2),VFR(2),o[0]), C1,0); \
    KRD(GL,3); GAPB(o[1]=mfma16(PAF(2),VFR(6),o[1]), C1,4); \
    GAPB(o[0]=mfma16(PAF(3),VFR(3),o[0]), C1,8); \
    GAPB(o[1]=mfma16(PAF(3),VFR(7),o[1]), C1,12); \
    }while(0)
  int t=1;
  for(;t+5<NT;t+=2){
    STEP(pB0,pB1,pA0,pA1,t,true,true,true,mO,mE);     WAIT_BAR(2); RESC(); ROT();
    STEP(pA0,pA1,pB0,pB1,t+1,true,true,true,mE,mO);   WAIT_BAR(2); RESC(); ROT();
  }
  #define ENDW(tt) do{ if((tt)+3<NT){WAIT_BAR(2);} else if((tt)+2<NT){WAIT_BAR(1);} else {WAIT_BAR(0);} }while(0)
  for(;t+1<NT;t+=2){
    STEP(pB0,pB1,pA0,pA1,t,(t+3<NT),(t+1<NT),(t+1<NT),mO,mE);       ENDW(t);   RESC(); ROT();
    STEP(pA0,pA1,pB0,pB1,t+1,(t+4<NT),(t+2<NT),(t+2<NT),mE,mO);     ENDW(t+1); RESC(); ROT();
  }
  STEP(pB0,pB1,pA0,pA1,NT-1,false,false,false,mO,mE); RESC();
  { float sacc=pB0[0]+pB0[1]; _Pragma("unroll") for(int r=2;r<16;++r)sacc+=pB0[r]; _Pragma("unroll") for(int r=0;r<16;++r)sacc+=pB1[r]; l_reg+=sacc;
    pw0=(u32x4){PKW(pB0,0),PKW(pB0,2),PKW(pB0,4),PKW(pB0,6)};pw1=(u32x4){PKW(pB0,8),PKW(pB0,10),PKW(pB0,12),PKW(pB0,14)};pw2=(u32x4){PKW(pB1,0),PKW(pB1,2),PKW(pB1,4),PKW(pB1,6)};pw3=(u32x4){PKW(pB1,8),PKW(pB1,10),PKW(pB1,12),PKW(pB1,14)};
    SBAR(); pv(o,vb0+sl_cur,PAF(0),PAF(1),PAF(2),PAF(3)); }
  #undef PKW
  #undef PAF
  #undef VFR
  #undef PIN
  #undef MX3
  #undef GAPA
  #undef GAPB
  #undef EX
  #undef VRD
  #undef KRD
  #undef STEP
  #undef ENDW
  {auto rr=__builtin_amdgcn_permlane32_swap(__float_as_uint(l_reg),__float_as_uint(l_reg),false,false);l_reg=__uint_as_float(rr[0])+__uint_as_float(rr[1]);}
  if(hi==0)wsf[32+r32]=l_reg;asm volatile("s_waitcnt lgkmcnt(0)":::"memory");
  float rli[16];
  #pragma unroll
  for(int r=0;r<16;++r)rli[r]=__builtin_amdgcn_rcpf(wsf[32+crow(r,hi)]);
  bf16*Ow=O+(rowbase+q0+wid*QBLK)*ODM+h*D;
  { bf16*stg=(bf16*)(shm+LDS_OST)+wid*2048;
    #pragma unroll
    for(int r=0;r<16;++r){const int orow=crow(r,hi);
      #pragma unroll
      for(int d0=0;d0<2;++d0)stg[orow*64+d0*32+r32]=(bf16)(o[d0][r]*rli[r]);}
    asm volatile("s_waitcnt lgkmcnt(0)":::"memory");
    #pragma unroll
    for(int i=0;i<4;++i){const int row=i*8+(lane>>3),ch=lane&7; const u32x4 v=*(const u32x4*)(stg+row*64+ch*8); ATTN_STORE16(Ow+(long)row*ODM+ch*8,v);
      const hx8 hv=__builtin_bit_cast(hx8,v); float sq=0.f;
      #pragma unroll
      for(int e=0;e<8;++e){const float f=(float)hv[e]; sq+=f*f;}
      sq+=__shfl_xor(sq,1); sq+=__shfl_xor(sq,2); sq+=__shfl_xor(sq,4);
      if(ch==0)atomicAdd(SSQ+rowbase+q0+wid*QBLK+row,sq);} }
  asm volatile("s_waitcnt lgkmcnt(0)\n\ts_barrier":::"memory");
  #undef DMA_K
  #undef DMA_V
  #undef MASKLD
  #undef START
  #undef RESC
  #undef ROT
}
constexpr int ATTN_LDS_BYTES=LDS_BYTES;
struct AttnTensors { const bf16* Q; const bf16* K; const bf16* V; bf16* O; const unsigned long long* MT; float* SSQ; };
struct AttnUnit { int bh; int qb; };
struct StaticOrder {
  int bh_, slot;
  __device__ __forceinline__ explicit StaticOrder(int grid,int block):bh_(block&31),slot((block>>5)&7){ (void)grid; }
  __device__ __forceinline__ bool next(int i,AttnUnit&u)const{
    int q=-1;
    if(slot==0){ if(i==0)q=15; }
    else if(slot<4){ if(i==0)q=15-slot; else if(i==1)q=slot-1; }
    else if(slot<7){ if(i==0)q=15-slot; else if(i==1)q=slot+1; }
    else { if(i==0)q=8; else if(i==1)q=4; else if(i==2)q=3; }
    if(q<0)return false; u.bh=bh_; u.qb=q; return true; }
  __device__ __forceinline__ void a_ready(const AttnUnit&)const{}
  __device__ __forceinline__ void done(const AttnUnit&)const{}
};
template<class Sched,int THRL=8> __device__ __forceinline__ void attn_phase(char*lds,const AttnTensors&T,const Sched&S){
  AttnUnit u;
  for(int i=0;S.next(i,u);++i){ S.a_ready(u); attn_unit<THRL>(u.bh/NHEAD,u.bh%NHEAD,u.qb,T.Q,T.K,T.V,T.O,T.MT,T.SSQ,lds); S.done(u); }
}
#undef SBAR
#undef WAIT_BAR
}

__device__ __forceinline__ void p6_mix_rows(const Params& p, int gw, int NGW, int lane) {
    const h16* YG = (const h16*)(p.ws + WS_YG); const h16* YA = (const h16*)(p.ws + WS_YA); h16* YMIX = (h16*)(p.ws + WS_YMIX);
    for (int m = gw; m < M; m += NGW) {
#pragma unroll
        for (int half = 0; half < 2; ++half) {
            const h16* src = (half ? YA : YG) + (size_t)m * 512 + 8 * lane; const float* gwt = (half ? p.on_attn : p.on_ssm) + 8 * lane;
            const h16x8 v = *(const h16x8*)src; float f[8]; float s = 0.f;
#pragma unroll
            for (int e = 0; e < 8; ++e) { f[e] = (float)v[e]; s += f[e] * f[e]; }
            const float rstd = 1.0f / sqrtf(wave_sum(s) * (1.0f / 512.0f) + EPS);
            const f32x4 g0 = *(const f32x4*)gwt, g1 = *(const f32x4*)(gwt + 4);
            u32x4 w; w.x = pkh(f[0] * rstd * g0[0], f[1] * rstd * g0[1]); w.y = pkh(f[2] * rstd * g0[2], f[3] * rstd * g0[3]);
            w.z = pkh(f[4] * rstd * g1[0], f[5] * rstd * g1[1]); w.w = pkh(f[6] * rstd * g1[2], f[7] * rstd * g1[3]);
            *(u32x4*)(YMIX + (size_t)m * DM + half * 512 + 8 * lane) = w;
        }
    }
}

#define XB_TMO      128
#define XB_XCNT(j)  (256  + 64 * (j))
#define XB_XSUB(j)  (1280 + 64 * (j))
#define XB_XGEN(j)  (2304 + 64 * (j))
#define XB_TOP      3328
#define XB_TOPGEN   3392
#define XCD_BAR_WORDS 3456
#define XB_SPIN_CAP (1u << 18)

__device__ __forceinline__ unsigned xb_ld(unsigned* p)              { return __hip_atomic_load(p, __ATOMIC_RELAXED, __HIP_MEMORY_SCOPE_AGENT); }
__device__ __forceinline__ unsigned xb_add(unsigned* p, unsigned v) { return __hip_atomic_fetch_add(p, v, __ATOMIC_RELAXED, __HIP_MEMORY_SCOPE_AGENT); }
__device__ __forceinline__ unsigned xb_xcc_id() { return (unsigned)__builtin_amdgcn_s_getreg((3 << 11) | 20) & 0xFu; }
#define XB_SPIN(cond, bar) do { unsigned _sp = 0; while (cond) { __builtin_amdgcn_s_sleep(1); \
    if ((++_sp & 255u) == 0u) { if (xb_ld(&(bar)[XB_TMO])) break; if (_sp > XB_SPIN_CAP) { atomicAdd(&(bar)[XB_TMO], 1u); break; } } } } while (0)

struct XcdBarrier {
    unsigned* bar; unsigned x;
    volatile LAS unsigned* st;
};

__device__ __forceinline__ XcdBarrier xcd_barrier_post(unsigned* bar, volatile LAS unsigned* st) {
    XcdBarrier b; b.bar = bar; b.x = xb_xcc_id(); b.st = st;
    if (threadIdx.x == 0) (void)xb_add(&bar[XB_XCNT(b.x)], 1u);
    return b;
}
__device__ __forceinline__ void xcd_barrier_complete(unsigned* bar, unsigned x, unsigned& nloc, unsigned& nx) {
    const unsigned G = gridDim.x * gridDim.y * gridDim.z;
    unsigned sum, cnt, mine, sp = 0u;
    for (;;) {
        sum = 0u; cnt = 0u; mine = 0u;
#pragma unroll
        for (unsigned j = 0; j < 16; ++j) { const unsigned c = xb_ld(&bar[XB_XCNT(j)]); sum += c; cnt += (c > 0u) ? 1u : 0u; mine = (j == x) ? c : mine; }
        if (sum == G) break;
        __builtin_amdgcn_s_sleep(1);
        if ((++sp & 255u) == 0u) { if (xb_ld(&bar[XB_TMO])) break; if (sp > XB_SPIN_CAP) { atomicAdd(&bar[XB_TMO], 1u); break; } }
    }
    nloc = mine > 0u ? mine : 1u; nx = cnt > 0u ? cnt : 1u;
}

__device__ __forceinline__ void xcd_barrier(const XcdBarrier& b) {
    asm volatile("s_waitcnt vmcnt(0)" ::: "memory");
    __syncthreads();
    if (threadIdx.x == 0) {
        unsigned* bar = b.bar;
        __builtin_amdgcn_s_waitcnt(0);
        unsigned nloc = b.st[0], nx = b.st[1];
        if (nloc == 0u) { xcd_barrier_complete(bar, b.x, nloc, nx); b.st[0] = nloc; b.st[1] = nx; }
        const unsigned old = xb_add(&bar[XB_XSUB(b.x)], 1u);
        const unsigned gen = old / nloc;
        if (old + 1u == (gen + 1u) * nloc) {
            __builtin_amdgcn_fence(__ATOMIC_RELEASE, "agent");
            asm volatile("s_waitcnt vmcnt(0)" ::: "memory");
            const unsigned og = xb_add(&bar[XB_TOP], 1u);
            const unsigned tg = og / nx;
            if (og + 1u == (tg + 1u) * nx) xb_add(&bar[XB_TOPGEN], 1u);
            else XB_SPIN(xb_ld(&bar[XB_TOPGEN]) == tg, bar);
            __builtin_amdgcn_fence(__ATOMIC_ACQUIRE, "agent");
            xb_add(&bar[XB_XGEN(b.x)], 1u);
            asm volatile("s_waitcnt vmcnt(0)" ::: "memory");
        } else {
            XB_SPIN(xb_ld(&bar[XB_XGEN(b.x)]) == gen, bar);
            __builtin_amdgcn_fence(__ATOMIC_ACQUIRE, "agent");
            asm volatile("s_waitcnt vmcnt(0)" ::: "memory");
        }
    }
    __syncthreads();
}

__global__ void __launch_bounds__(NT, 2) fwd_mega(Params p) {
    extern __shared__ __attribute__((aligned(16))) unsigned char lds_raw[];
    LAS unsigned char* lds = (LAS unsigned char*)lds_raw;
    cg::grid_group grid = cg::this_grid();
    const int tid = threadIdx.x, lane = tid & 63, wave = __builtin_amdgcn_readfirstlane(tid >> 6);
    const int G = gridDim.x, gw = blockIdx.x * NWAVES + wave, NGW = G * NWAVES;
    unsigned char* ws = p.ws;
    unsigned* ctl = (unsigned*)(ws + WS_CTL);
    const float* MOD = (const float*)(ws + WS_CTL + CTL_MOD_OFF);
    h16* HN = (h16*)(ws + WS_HN);
    volatile LAS unsigned* bst = (volatile LAS unsigned*)(lds + LDS_BYTES - 32);
    if (tid < 2) bst[tid] = 0u;
    __syncthreads();
    const XcdBarrier bar = xcd_barrier_post(ctl + CW_BAR, bst);
#define GRID_BAR() xcd_barrier(bar)

    p0_prologue(p, lds, gw, NGW, wave, lane);
    for (int it = (int)blockIdx.x; it < NG * 8; it += G) s5_tables(p, it, lds);
    if (p.use_cg_sync) grid.sync();
    GRID_BAR();
    norm_mod_rows(p.x, p.norm_mix, MOD, 0, DM, HN, gw, NGW, lane);
    GRID_BAR();
    bias2_rows(p, MOD, gw, NGW, lane);
    { pg8::Gemm g{HN, (const h16*)(ws + WS_WIN), M, NPROJ_PAD, DM, DM}; pg8::StaticOrder S; S.init(M, NPROJ_PAD, G, (int)blockIdx.x);
      const float* RCp = (const float*)(ws + WS_ROPE);
      EpiProj E{(h16*)(ws + WS_U), (h16*)(ws + WS_Q), (h16*)(ws + WS_K), (h16*)(ws + WS_V), (h16*)(ws + WS_QI), (h16*)(ws + WS_KIF), (float*)(ws + WS_WI), RCp, RCp + (size_t)M * 32, p.q_norm, p.k_norm};
      pg8::gemm_phase<EpiProj, pg8::StaticOrder, true, true>(lds, g, S, E); }
    GRID_BAR();
    {
        LAS int* slot = (LAS int*)(lds + LDS_BYTES - 64);
        int nxt = (int)blockIdx.x;
        if ((int)blockIdx.x < NB * NG) {
            if (tid == 0) nxt = (int)atomicAdd(ctl + CW_Q4, 1u) + (int)gridDim.x;
            s5_unit_mfma(p, (int)blockIdx.x, lds);
        }
        TilePf16 pf; pf.tok0 = -1;
        for (;;) {
            lds_barrier();
            if (tid == 0) *slot = nxt;
            lds_barrier();
            const int it = *slot;
            if (it >= NB * NG + M / 16) break;
            if (tid == 0) nxt = (int)atomicAdd(ctl + CW_Q4, 1u) + (int)gridDim.x;
            select_tile16(p, queue_tok0_16(it), lds, pf, nxt);
        }
    }
    GRID_BAR();
    {
        const attn_body::AttnTensors AT{(const h16*)(ws + WS_Q), (const h16*)(ws + WS_K), (const h16*)(ws + WS_V), (h16*)(ws + WS_YMIX) + 512, (const unsigned long long*)(ws + WS_MASK), (float*)(ws + WS_CTL + CTL_SSQA_OFF)};
        const attn_body::StaticOrder SA((int)G, (int)blockIdx.x);
        attn_body::attn_phase<attn_body::StaticOrder>((char*)lds_raw, AT, SA);
        pg8::Gemm g{(const h16*)(ws + WS_YS), (const h16*)(ws + WS_WGLU), M, DSSM, DSSM, DSSM}; pg8::StaticOrder S; S.init(M, DSSM, G, (int)blockIdx.x);
        EpiGlu E{(const h16*)(ws + WS_YS), (h16*)(ws + WS_YMIX), p.b_glu, (float*)(ws + WS_CTL + CTL_SSQS_OFF)};
        pg8::gemm_phase<EpiGlu, pg8::StaticOrder, true, true>(lds, g, S, E);
    }
    GRID_BAR();
    { pg8::Gemm g{(const h16*)(ws + WS_YMIX), (const h16*)(ws + WS_WOUT), M, DM, DM, DM}; pg8::StaticOrder S; S.init(M, DM, G, (int)blockIdx.x);
      EpiResidNorm E{p.x, (h16*)(ws + WS_H1), MOD + 2 * DM, p.norm_ffn, MOD + 4 * DM, HN, (float*)(ws + WS_CTL + CTL_SSQ2_OFF), (const float*)(ws + WS_CTL + CTL_SSQS_OFF), (const float*)(ws + WS_CTL + CTL_SSQA_OFF)};
      pg8::gemm_phase<EpiResidNorm, pg8::StaticOrder, true, true>(lds, g, S, E); }
    GRID_BAR();
    { pg8::Gemm g{HN, (const h16*)(ws + WS_WUP), M, DUP, DM, DM}; pg8::StaticOrder S; S.init(M, DUP, G, (int)blockIdx.x);
      EpiUpConv E{(h16*)(ws + WS_UP), (const float*)(ws + WS_CTL + CTL_SSQ2_OFF), (const float*)(ws + WS_BIAS2), (h16*)(ws + WS_HALO), p.conv_w, p.conv_b};
      pg8::gemm_phase<EpiUpConv, pg8::StaticOrder, true, true>(lds, g, S, E); }
    GRID_BAR();
    { pg8::Gemm g{(const h16*)(ws + WS_UP), (const h16*)(ws + WS_WDOWN), M, DM, DFF, DFF}; pg8::StaticOrder S; S.init(M, DM, G, (int)blockIdx.x);
      { pg8::Unit u0; if (S.next(0, u0)) {
        const h16* SBp = (const h16*)(ws + WS_HALO); h16* A2 = (h16*)(ws + WS_UP);
        for (int it_ = tid; it_ < 2 * (DFF / 8); it_ += NT) { const int item = (2 * u0.pm) * (DFF / 8) + it_;
            const int grp = item / (DFF / 8), lcol = 8 * (item % (DFF / 8)), pcol = 256 * (lcol >> 7) + (lcol & 127), T = 128 * grp;
            const h16* sb = SBp + (size_t)grp * 4 * DUP + pcol;
            h16x8 gq[4], vq[4];
#pragma unroll
            for (int r_ = 0; r_ < 4; ++r_) { gq[r_] = (h16x8){}; vq[r_] = (h16x8){}; }
            if ((T % SL) != 0) { gq[0] = *(const h16x8*)sb; vq[0] = *(const h16x8*)(sb + 128); gq[1] = *(const h16x8*)(sb + DUP); vq[1] = *(const h16x8*)(sb + DUP + 128); }
            gq[2] = *(const h16x8*)(sb + 2 * DUP); vq[2] = *(const h16x8*)(sb + 2 * DUP + 128); gq[3] = *(const h16x8*)(sb + 3 * DUP); vq[3] = *(const h16x8*)(sb + 3 * DUP + 128);
            float o0[8], o1[8];
#pragma unroll
            for (int e = 0; e < 8; ++e) {
                const float wg0 = p.conv_w[lcol + e], wg1 = p.conv_w[DUP + lcol + e], wg2 = p.conv_w[2 * DUP + lcol + e], bgc = p.conv_b[lcol + e];
                const float wv0 = p.conv_w[DFF + lcol + e], wv1 = p.conv_w[DUP + DFF + lcol + e], wv2 = p.conv_w[2 * DUP + DFF + lcol + e], bvc = p.conv_b[DFF + lcol + e];
                const float cg0 = bgc + wg0 * (float)gq[0][e] + wg1 * (float)gq[1][e] + wg2 * (float)gq[2][e], cv0 = bvc + wv0 * (float)vq[0][e] + wv1 * (float)vq[1][e] + wv2 * (float)vq[2][e];
                const float cg1 = bgc + wg0 * (float)gq[1][e] + wg1 * (float)gq[2][e] + wg2 * (float)gq[3][e], cv1 = bvc + wv0 * (float)vq[1][e] + wv1 * (float)vq[2][e] + wv2 * (float)vq[3][e];
                o0[e] = gelu_tanh(cg0) * cv0; o1[e] = gelu_tanh(cg1) * cv1; }
            u32x4 w0_, w1_; w0_.x = pkh(o0[0], o0[1]); w0_.y = pkh(o0[2], o0[3]); w0_.z = pkh(o0[4], o0[5]); w0_.w = pkh(o0[6], o0[7]);
            w1_.x = pkh(o1[0], o1[1]); w1_.y = pkh(o1[2], o1[3]); w1_.z = pkh(o1[4], o1[5]); w1_.w = pkh(o1[6], o1[7]);
            *(u32x4*)(A2 + (size_t)T * DFF + lcol) = w0_; *(u32x4*)(A2 + (size_t)(T + 1) * DFF + lcol) = w1_;
        }
        asm volatile("s_waitcnt vmcnt(0)" ::: "memory"); __syncthreads(); } }
      EpiResid E{(const h16*)(ws + WS_H1), p.out, MOD + 5 * DM};
      pg8::gemm_phase<EpiResid, pg8::StaticOrder, true, true>(lds, g, S, E); }
}

extern "C" void kernel_launch(void* const* d_in, const int* in_sizes, int n_in, void* d_out, int out_size, void* d_ws, size_t ws_size, hipStream_t stream) {
    static int grid = 0;
    if (grid == 0) {
        if (n_in != 27 || in_sizes[0] != M * DM || out_size != M * DM || ws_size < WS_END) { fprintf(stderr, "kernel_launch: unexpected shapes (n_in %d, in0 %d, out %d, ws %zu)\n", n_in, n_in > 0 ? in_sizes[0] : -1, out_size, ws_size); grid = -1; return; }
        int dev = 0, cus = 0, per_cu = 0;
        (void)hipGetDevice(&dev); (void)hipDeviceGetAttribute(&cus, hipDeviceAttributeMultiprocessorCount, dev);
        if (hipFuncSetAttribute((const void*)fwd_mega, hipFuncAttributeMaxDynamicSharedMemorySize, LDS_BYTES) != hipSuccess) { fprintf(stderr, "kernel_launch: hipFuncSetAttribute failed\n"); grid = -1; return; }
        if (hipOccupancyMaxActiveBlocksPerMultiprocessor(&per_cu, (const void*)fwd_mega, NT, LDS_BYTES) != hipSuccess || per_cu < 1) { fprintf(stderr, "kernel_launch: occupancy query reports %d\n", per_cu); grid = -1; return; }
        grid = cus;
        if (grid != 256) { fprintf(stderr, "kernel_launch: built for 256 CUs, got %d\n", grid); grid = -1; return; }
    }
    if (grid < 0) return;
    (void)hipMemsetAsync((char*)d_ws + WS_CTL, 0, CTL_ZERO_BYTES, stream);
    Params p{};
    const float* const* in = (const float* const*)d_in;
    p.x = in[0]; p.c = in[1]; p.positions = (const int*)d_in[2]; p.w_ada = in[3]; p.b_ada = in[4]; p.norm_mix = in[5]; p.w_in = in[6]; p.log_dt = in[7];
    p.a_re = in[8]; p.a_im = in[9]; p.b_re = in[10]; p.b_im = in[11]; p.c_re = in[12]; p.c_im = in[13]; p.ssm_d = in[14]; p.w_glu = in[15]; p.b_glu = in[16];
    p.q_norm = in[17]; p.k_norm = in[18]; p.on_ssm = in[19]; p.on_attn = in[20]; p.w_out = in[21]; p.norm_ffn = in[22]; p.w_up = in[23]; p.conv_w = in[24];
    p.conv_b = in[25]; p.w_down = in[26]; p.out = (float*)d_out; p.ws = (unsigned char*)d_ws; p.use_cg_sync = 0ull;
    void* args[] = {&p};
    const hipError_t e = hipLaunchCooperativeKernel((const void*)fwd_mega, dim3(grid), dim3(NT), args, LDS_BYTES, stream);
    if (e != hipSuccess) fprintf(stderr, "kernel_launch: cooperative launch failed: %s (grid %d)\n", hipGetErrorString(e), grid);
}
```
